# Optimizing an MI355X kernel written in HIP

```python
import math
import jax
import jax.numpy as jnp
from jax import lax
import numpy as np

D_MODEL = 1024
BATCH = 1
SEQ = 16384
DEPTH = 1

HEAD_DIM = 64
N_HEADS_FOX = 8
N_HEADS_MOBA = 8
FOX_WIDTH = N_HEADS_FOX * HEAD_DIM
MOBA_WIDTH = N_HEADS_MOBA * HEAD_DIM
MIX_WIDTH = FOX_WIDTH + MOBA_WIDTH
IN_WIDTH = 3 * FOX_WIDTH + 3 * MOBA_WIDTH + N_HEADS_FOX
Q_BLOCK = 128
MOBA_BLOCK = 256
MOBA_TOPK = 3
MOBA_Q_CHUNK = 64
NUM_BUCKETS = 32
MAX_DISTANCE = 128
N_EXPERTS = 32
TOP_K = 4
D_EXPERT = D_MODEL
SWIGLU_LIMIT = 7.0
SWIGLU_ALPHA = 1.702
EXPERT_ROW_BLOCK = 128
RMS_EPS = 1e-6

kernel_name = "hybrid_fox_moba_moe_block"


def rms_norm(x, g):
    x32 = x.astype(jnp.float32)
    y = x32 * lax.rsqrt(jnp.mean(x32 * x32, axis=-1, keepdims=True) + RMS_EPS)
    return (y * g.astype(jnp.float32)).astype(x.dtype)


def t5_bucket(dist):
    dist = jnp.maximum(dist, 0)
    max_exact = NUM_BUCKETS // 2
    d = jnp.maximum(dist, 1).astype(jnp.float32)
    large = max_exact + (jnp.log(d / max_exact) / math.log(MAX_DISTANCE / max_exact)
                         * (NUM_BUCKETS - max_exact)).astype(jnp.int32)
    large = jnp.minimum(large, NUM_BUCKETS - 1)
    return jnp.where(dist < max_exact, dist, large)


def fox_attention(q, k, v, log_f):
    B, S, H, Dh = q.shape
    scale = Dh ** -0.5
    cum = jnp.cumsum(log_f, axis=1)
    cum_h = cum.transpose(0, 2, 1)
    kh = k.transpose(0, 2, 1, 3)
    vh = v.transpose(0, 2, 1, 3)
    nq = S // Q_BLOCK
    qb = q.reshape(B, nq, Q_BLOCK, H, Dh).transpose(1, 0, 3, 2, 4)
    cb = cum.reshape(B, nq, Q_BLOCK, H).transpose(1, 0, 3, 2)
    key_pos = jnp.arange(S)

    def block(args):
        i, qi, ci = args
        s = jnp.einsum('bhqd,bhkd->bhqk', qi, kh).astype(jnp.float32) * scale
        s = s + ci[..., None] - cum_h[:, :, None, :]
        qpos = i * Q_BLOCK + jnp.arange(Q_BLOCK)
        s = jnp.where(key_pos[None, :] <= qpos[:, None], s, -jnp.inf)
        p = jax.nn.softmax(s, axis=-1)
        return jnp.einsum('bhqk,bhkd->bhqd', p.astype(vh.dtype), vh)

    out = lax.map(block, (jnp.arange(nq), qb, cb))
    return out.transpose(1, 0, 3, 2, 4).reshape(B, S, H, Dh)


def moba_attention(q, k, v, rel_bias):
    B, S, H, Dh = q.shape
    scale = Dh ** -0.5
    s_pad = -(-S // MOBA_BLOCK) * MOBA_BLOCK
    pad = ((0, 0), (0, s_pad - S), (0, 0), (0, 0))
    q, k, v = jnp.pad(q, pad), jnp.pad(k, pad), jnp.pad(v, pad)
    nb = s_pad // MOBA_BLOCK
    k_sel_n = min(MOBA_TOPK, nb)
    kb = k.reshape(B, nb, MOBA_BLOCK, H, Dh).transpose(0, 3, 1, 2, 4)
    vb = v.reshape(B, nb, MOBA_BLOCK, H, Dh).transpose(0, 3, 1, 2, 4)
    kmean = jnp.mean(kb.astype(jnp.float32), axis=3)
    nq = s_pad // MOBA_Q_CHUNK
    qc = q.reshape(B, nq, MOBA_Q_CHUNK, H, Dh).transpose(1, 0, 2, 3, 4)
    bi = jnp.arange(B)[:, None, None, None]
    hi = jnp.arange(H)[None, None, :, None]
    hi5 = jnp.arange(H)[None, None, :, None, None]
    blk_pos = jnp.arange(MOBA_BLOCK)

    def chunk(args):
        i, qi = args
        qpos = i * MOBA_Q_CHUNK + jnp.arange(MOBA_Q_CHUNK)
        own = (i * MOBA_Q_CHUNK) // MOBA_BLOCK
        gate = jnp.einsum('bqhd,bhnd->bqhn', qi.astype(jnp.float32), kmean)
        gate = jnp.where(jnp.arange(nb) < own, gate, -jnp.inf)
        _, idx = lax.top_k(gate, k_sel_n)
        valid = jnp.arange(k_sel_n) < own
        ksel = kb[bi, hi, idx]
        vsel = vb[bi, hi, idx]
        s_sel = jnp.einsum('bqhd,bqhjpd->bqhjp', qi, ksel).astype(jnp.float32) * scale
        kpos_sel = idx[..., None] * MOBA_BLOCK + blk_pos
        dist_sel = qpos[None, :, None, None, None] - kpos_sel
        s_sel = s_sel + rel_bias[t5_bucket(dist_sel), hi5].astype(jnp.float32)
        s_sel = jnp.where(valid[None, None, None, :, None], s_sel, -jnp.inf)
        k_own = lax.dynamic_index_in_dim(kb, own, axis=2, keepdims=False)
        v_own = lax.dynamic_index_in_dim(vb, own, axis=2, keepdims=False)
        s_own = jnp.einsum('bqhd,bhpd->bqhp', qi, k_own).astype(jnp.float32) * scale
        dist_own = qpos[:, None] - (own * MOBA_BLOCK + blk_pos)[None, :]
        bias_own = rel_bias[t5_bucket(dist_own)].transpose(0, 2, 1)
        s_own = s_own + bias_own[None].astype(jnp.float32)
        s_own = jnp.where((dist_own >= 0)[None, :, None, :], s_own, -jnp.inf)
        logits = jnp.concatenate(
            [s_sel.reshape(B, MOBA_Q_CHUNK, H, k_sel_n * MOBA_BLOCK), s_own], axis=-1)
        p = jax.nn.softmax(logits, axis=-1).astype(vb.dtype)
        p_sel = p[..., :k_sel_n * MOBA_BLOCK].reshape(B, MOBA_Q_CHUNK, H, k_sel_n, MOBA_BLOCK)
        p_own = p[..., k_sel_n * MOBA_BLOCK:]
        return (jnp.einsum('bqhjp,bqhjpd->bqhd', p_sel, vsel)
                + jnp.einsum('bqhp,bhpd->bqhd', p_own, v_own))

    out = lax.map(chunk, (jnp.arange(nq), qc))
    return out.transpose(1, 0, 2, 3, 4).reshape(B, s_pad, H, Dh)[:, :S]


def clamped_swiglu(hdn):
    x_glu = jnp.minimum(hdn[..., :D_EXPERT], SWIGLU_LIMIT)
    x_lin = jnp.clip(hdn[..., D_EXPERT:], -SWIGLU_LIMIT, SWIGLU_LIMIT)
    return x_glu * jax.nn.sigmoid(SWIGLU_ALPHA * x_glu) * (x_lin + 1)


def moe_ffn(h, w_router, b_router, w_gate_up, b_gate_up, w_down, b_down):
    B, S, D = h.shape
    T = B * S
    xt = h.reshape(T, D)
    logits = (xt @ w_router).astype(jnp.float32) + b_router.astype(jnp.float32)
    top_v, top_i = lax.top_k(logits, TOP_K)
    gates = jax.nn.softmax(top_v, axis=-1)
    A = T * TOP_K
    e_flat = top_i.reshape(A)
    tok_flat = jnp.arange(A) // TOP_K
    g_flat = gates.reshape(A)
    order = jnp.argsort(e_flat)
    e_sorted, tok_sorted, g_sorted = e_flat[order], tok_flat[order], g_flat[order]
    counts = jnp.bincount(e_flat, length=N_EXPERTS)
    padded = ((counts + EXPERT_ROW_BLOCK - 1) // EXPERT_ROW_BLOCK) * EXPERT_ROW_BLOCK
    starts = jnp.cumsum(counts) - counts
    pends = jnp.cumsum(padded)
    pstarts = pends - padded
    dest = pstarts[e_sorted] + jnp.arange(A) - starts[e_sorted]
    n_rows = A + N_EXPERTS * EXPERT_ROW_BLOCK
    n_blk = n_rows // EXPERT_ROW_BLOCK
    rows = jnp.zeros((n_rows, D), xt.dtype).at[dest].set(xt[tok_sorted])
    block_e = jnp.minimum(
        jnp.searchsorted(pends, jnp.arange(n_blk) * EXPERT_ROW_BLOCK, side='right'), N_EXPERTS - 1)

    def expert_block(args):
        xb, e = args
        hdn = xb @ w_gate_up[e] + b_gate_up[e]
        return clamped_swiglu(hdn) @ w_down[e] + b_down[e]

    y = lax.map(expert_block, (rows.reshape(n_blk, EXPERT_ROW_BLOCK, D), block_e)).reshape(n_rows, D)
    out = jnp.zeros((T, D), y.dtype).at[tok_sorted].add(y[dest] * g_sorted[:, None].astype(y.dtype))
    return out.reshape(B, S, D)


def setup_inputs(seed: int = 0) -> dict:
    key = jax.random.key(seed)
    ks = jax.random.split(key, 20)
    nrm = jax.random.normal
    f32 = jnp.float32
    return {
        "x": nrm(ks[0], (BATCH, SEQ, D_MODEL), f32),
        "c": nrm(ks[1], (BATCH, D_MODEL), f32),
        "w_ada": nrm(ks[2], (DEPTH, D_MODEL, 6 * D_MODEL), f32) * (0.5 * D_MODEL ** -0.5),
        "b_ada": nrm(ks[3], (DEPTH, 6 * D_MODEL), f32) * 0.01,
        "g_pre_mix": 1.0 + 0.05 * nrm(ks[4], (DEPTH, D_MODEL), f32),
        "g_post_mix": 1.0 + 0.05 * nrm(ks[5], (DEPTH, D_MODEL), f32),
        "w_in": nrm(ks[6], (DEPTH, D_MODEL, IN_WIDTH), f32) * D_MODEL ** -0.5,
        "b_forget": nrm(ks[7], (DEPTH, N_HEADS_FOX), f32) * 0.1,
        "rel_bias": nrm(ks[8], (NUM_BUCKETS, N_HEADS_MOBA), f32) * 0.5,
        "w_out": nrm(ks[9], (DEPTH, MIX_WIDTH, D_MODEL), f32) * MIX_WIDTH ** -0.5,
        "g_pre_ffn": 1.0 + 0.05 * nrm(ks[10], (DEPTH, D_MODEL), f32),
        "g_post_ffn": 1.0 + 0.05 * nrm(ks[11], (DEPTH, D_MODEL), f32),
        "w_router": nrm(ks[12], (DEPTH, D_MODEL, N_EXPERTS), f32) * D_MODEL ** -0.5,
        "b_router": nrm(ks[13], (DEPTH, N_EXPERTS), f32) * 0.01,
        "w_gate_up": nrm(ks[14], (DEPTH, N_EXPERTS, D_MODEL, 2 * D_EXPERT), f32) * D_MODEL ** -0.5,
        "b_gate_up": nrm(ks[15], (DEPTH, N_EXPERTS, 2 * D_EXPERT), f32) * 0.01,
        "w_down": nrm(ks[16], (DEPTH, N_EXPERTS, D_EXPERT, D_MODEL), f32) * D_EXPERT ** -0.5,
        "b_down": nrm(ks[17], (DEPTH, N_EXPERTS, D_MODEL), f32) * 0.01,
    }


def reference(x, c, w_ada, b_ada, g_pre_mix, g_post_mix, w_in, b_forget, rel_bias, w_out,
              g_pre_ffn, g_post_ffn, w_router, b_router, w_gate_up, b_gate_up, w_down, b_down):
    B, S, D = x.shape
    cond = jax.nn.silu(c)
    for l in range(DEPTH):
        mod = cond @ w_ada[l] + b_ada[l]
        sh_m, sc_m, gt_m, sh_f, sc_f, gt_f = jnp.split(mod, 6, axis=-1)
        h = rms_norm(x, g_pre_mix[l]) * (1 + sc_m[:, None, :]) + sh_m[:, None, :]
        proj = h @ w_in[l]
        o = np.cumsum([FOX_WIDTH] * 3 + [MOBA_WIDTH] * 3)
        q_a, k_a, v_a = proj[..., :o[0]], proj[..., o[0]:o[1]], proj[..., o[1]:o[2]]
        q_b, k_b, v_b = proj[..., o[2]:o[3]], proj[..., o[3]:o[4]], proj[..., o[4]:o[5]]
        f_logit = proj[..., o[5]:]
        log_f = jax.nn.log_sigmoid(f_logit.astype(jnp.float32) + b_forget[l].astype(jnp.float32))
        hs_a = (B, S, N_HEADS_FOX, HEAD_DIM)
        hs_b = (B, S, N_HEADS_MOBA, HEAD_DIM)
        y_a = fox_attention(q_a.reshape(hs_a), k_a.reshape(hs_a), v_a.reshape(hs_a), log_f)
        y_b = moba_attention(q_b.reshape(hs_b), k_b.reshape(hs_b), v_b.reshape(hs_b), rel_bias)
        mix = jnp.concatenate([y_a.reshape(B, S, FOX_WIDTH), y_b.reshape(B, S, MOBA_WIDTH)], axis=-1)
        x = x + gt_m[:, None, :] * rms_norm(mix @ w_out[l], g_post_mix[l])
        h = rms_norm(x, g_pre_ffn[l]) * (1 + sc_f[:, None, :]) + sh_f[:, None, :]
        y = moe_ffn(h, w_router[l], b_router[l], w_gate_up[l], b_gate_up[l], w_down[l], b_down[l])
        x = x + gt_f[:, None, :] * rms_norm(y, g_post_ffn[l])
    return x
```

```cpp
#include <hip/hip_runtime.h>
#include <hip/hip_bf16.h>
#include <cstdio>
#include <cstdint>
#include <cmath>
namespace pg8 {
#define PG8_LAS __attribute__((address_space(3)))
typedef unsigned short bf16_t;
typedef short bf16x8 __attribute__((ext_vector_type(8)));
typedef float f32x4 __attribute__((ext_vector_type(4)));
typedef unsigned u32x4 __attribute__((ext_vector_type(4)));
constexpr int BM = 256, BK = 64, HALF = 128, HTB = HALF * BK * 2  , STAGE_BYTES = 8 * HTB, NXCD = 8, WGM = 8;

__host__ __device__ __forceinline__ int lds_byte(int r, int c) { const int st = (r >> 4) * 2 + (c >> 5), rr = r & 15, cc = c & 31, ob = rr * 64 + cc * 2; return st * 1024 + (ob ^ (((ob >> 9) & 1) << 5)); }
__host__ __device__ __forceinline__ void stage_rc(int b, int& R, int& C) { const int st = b / 1024, sb = b % 1024, swz = sb ^ (((sb >> 9) & 1) << 5); R = (st >> 1) * 16 + swz / 64; C = (st & 1) * 32 + (swz % 64) / 2; }
__host__ __device__ __forceinline__ int perm32(int rho) { const int n = rho >> 4, i = rho & 15; return 8 * (i >> 2) + 4 * n + (i & 3); }

struct Unit { int pm, pn, pb, e; };
struct Gemm { const bf16_t* A; const bf16_t* Bt; int M, N, K; };

struct StaticOrder {
    int nM, nN, nwg, G, c;
    __host__ __device__ void init(int M, int N, int G_, int c_) { nM = M / BM; nN = N / BM; nwg = nM * nN; G = G_; c = c_; }
    __host__ __device__ bool next(int i, Unit& u) const {
        const long L = (long)i * G + c; if (L >= nwg) return false;
        int wgid = (int)L; { const int q = nwg / NXCD, r = nwg % NXCD, xcd = wgid % NXCD, off = wgid / NXCD; wgid = (xcd < r ? xcd * (q + 1) : r * (q + 1) + (xcd - r) * q) + off; }
        const int nig = WGM * nN, gid = wgid / nig, fm = gid * WGM, gsz = (nM - fm) < WGM ? (nM - fm) : WGM;
        u.pm = fm + ((wgid % nig) % gsz); u.pn = (wgid % nig) / gsz; u.pb = u.pn; u.e = 0; return true;
    }
    __device__ __forceinline__ void a_ready(const Unit&) const {}
    __device__ __forceinline__ void done(const Unit&) const {}
};

__device__ __forceinline__ unsigned cvt_pk_bf16(float lo, float hi) { unsigned r; asm volatile("v_cvt_pk_bf16_f32 %0, %1, %2" : "=v"(r) : "v"(lo), "v"(hi)); return r; }
typedef float f32x2 __attribute__((ext_vector_type(2)));
__device__ __forceinline__ f32x2 gelu_pk(f32x2 v) {
    const f32x2 av = __builtin_elementwise_abs(v), d = av * 0.2316418882f + 1.0f;
    f32x2 t; t.x = __builtin_amdgcn_rcpf(d.x); t.y = __builtin_amdgcn_rcpf(d.y);
    f32x2 q = t * 0.5307027145f + (-0.7265760135f); q = q * t + 0.7107068705f; q = q * t + (-0.142248368f); q = q * t + 0.127414796f; q = q * t;
    const f32x2 s = (v * v) * (-0.72134752044f);
    f32x2 e; e.x = __builtin_amdgcn_exp2f(s.x); e.y = __builtin_amdgcn_exp2f(s.y);
    const f32x2 m = v * (q * e), r = v - m;
    f32x2 o; o.x = v.x < 0.f ? m.x : r.x; o.y = v.y < 0.f ? m.y : r.y; return o;
}

template <int ACT  > struct EpiBf16 {
    static constexpr bool PERM = true, AFTER_DRAIN = false; static_assert(ACT == 0 || ACT == 1, "EpiBf16: ACT is 0 (none) or 1 (gelu_pk)");
    bf16_t* O; int ldc; const float* bias; int split_cols; size_t split_stride; float scale0;
    __device__ __forceinline__ void operator()(const f32x4 (&acc)[2][2][4][2], const Unit& u, int wr, int wc, int fr, int fq) const {
        const int row0 = u.pm * BM + wr * 64 + fr; int colt = u.pn * BM; bf16_t* base = O;
        float sc = 1.f; if (split_cols) { const int t = colt / split_cols; base += (size_t)t * split_stride; colt -= t * split_cols; if (t == 0) sc = scale0; }
        const int col0 = colt + wc * 32 + 8 * fq, bcol0 = u.pn * BM + wc * 32 + 8 * fq;
        f32x4 bv[2][2];
#pragma unroll
        for (int bj = 0; bj < 2; ++bj)
#pragma unroll
            for (int n = 0; n < 2; ++n) bv[bj][n] = bias ? *(const f32x4*)(bias + bcol0 + bj * HALF + 4 * n) : (f32x4){0.f, 0.f, 0.f, 0.f};
#pragma unroll
        for (int ai = 0; ai < 2; ++ai)
#pragma unroll
            for (int m = 0; m < 4; ++m) { bf16_t* rowp = base + (size_t)(row0 + ai * HALF + m * 16) * ldc + col0;
#pragma unroll
                for (int bj = 0; bj < 2; ++bj) { f32x4 v0 = acc[ai][bj][m][0] + bv[bj][0], v1 = acc[ai][bj][m][1] + bv[bj][1];
                    if (ACT == 1) { f32x2 a = gelu_pk((f32x2){v0[0], v0[1]}), b = gelu_pk((f32x2){v0[2], v0[3]}), c = gelu_pk((f32x2){v1[0], v1[1]}), d = gelu_pk((f32x2){v1[2], v1[3]});
                        v0 = (f32x4){a.x, a.y, b.x, b.y}; v1 = (f32x4){c.x, c.y, d.x, d.y}; }
                    v0 = v0 * sc; v1 = v1 * sc; u32x4 w; w.x = cvt_pk_bf16(v0[0], v0[1]); w.y = cvt_pk_bf16(v0[2], v0[3]); w.z = cvt_pk_bf16(v1[0], v1[1]); w.w = cvt_pk_bf16(v1[2], v1[3]);
                    *(u32x4*)(rowp + bj * HALF) = w; } }
    }
};
template <class Epi, class Sched, bool ALIGN_EPI = false, bool SP2 = false>
__device__ __forceinline__ void gemm_phase(PG8_LAS unsigned char* lds, const Gemm g, const Sched& S, const Epi& E) {
    const int tid = threadIdx.x, wid = __builtin_amdgcn_readfirstlane(tid >> 6), lane = tid & 63, wr = wid >> 2, wc = wid & 3, fr = lane & 15, fq = lane >> 4;
    const int K = g.K, nt = K / BK;
    unsigned voffA[2], voffB[2];
#pragma unroll
    for (int i = 0; i < 2; ++i) { int R, C; stage_rc(tid * 16 + i * 8192, R, C); const int Rb = Epi::PERM ? ((R & ~31) + perm32(R & 31)) : R;
        voffA[i] = (unsigned)(R * K + C) * 2u; voffB[i] = (unsigned)(Rb * K + C) * 2u; }
    const size_t kstep = (size_t)(BK * 2);
    const size_t hstep = (size_t)HALF * K * 2;
    const size_t tstep = 2 * hstep;
    const unsigned ldsw = (unsigned)wid * 1024u;
    const int aoff = lds_byte(wr * 64 + fr, fq * 8), boff = lds_byte(wc * 32 + fr, fq * 8);
#define PG8_SA(b, h) (((b) * 2 + (h)) * HTB)
#define PG8_SB(b, h) ((4 + (b) * 2 + (h)) * HTB)
#define PG8_STAGE(bufoff, gbase, voff) do { _Pragma("unroll") for (int _i = 0; _i < 2; ++_i) \
        __builtin_amdgcn_global_load_lds((const unsigned*)((const char*)(gbase) + (voff)[_i]), (PG8_LAS unsigned*)(lds + (bufoff) + ldsw + _i * 8192), 16, 0, 0); } while (0)
#define PG8_LDA(dst, b, h) do { _Pragma("unroll") for (int m = 0; m < 4; ++m) _Pragma("unroll") for (int k = 0; k < 2; ++k) dst[m][k] = *(const PG8_LAS bf16x8*)(lds + PG8_SA(b, h) + aoff + m * 2048 + k * 1024); } while (0)
#define PG8_LDB(dst, b, h) do { _Pragma("unroll") for (int n = 0; n < 2; ++n) _Pragma("unroll") for (int k = 0; k < 2; ++k) dst[n][k] = *(const PG8_LAS bf16x8*)(lds + PG8_SB(b, h) + boff + n * 2048 + k * 1024); } while (0)
#define PG8_MMA(ai, bj, At, Bt) do { __builtin_amdgcn_s_setprio(1); _Pragma("unroll") for (int m = 0; m < 4; ++m) _Pragma("unroll") for (int n = 0; n < 2; ++n) _Pragma("unroll") for (int k = 0; k < 2; ++k) \
        acc[ai][bj][m][n] = __builtin_amdgcn_mfma_f32_16x16x32_bf16(Bt[n][k], At[m][k], acc[ai][bj][m][n], 0, 0, 0); __builtin_amdgcn_s_setprio(0); } while (0)
#define PG8_WAIT_V(n) asm volatile("s_waitcnt vmcnt(" #n ")" ::: "memory")
#define PG8_WAIT_L(n) asm volatile("s_waitcnt lgkmcnt(" #n ")" ::: "memory")
#define PG8_BAR __builtin_amdgcn_s_barrier()
#define PG8_SCHED __builtin_amdgcn_sched_barrier(0)
    Unit cur, nxt; int ui = 0;
    if (!S.next(0, cur)) return;
    f32x4 acc[2][2][4][2];
#pragma unroll
    for (int a = 0; a < 2; ++a)
#pragma unroll
        for (int b = 0; b < 2; ++b)
#pragma unroll
            for (int m = 0; m < 4; ++m)
#pragma unroll
                for (int n = 0; n < 2; ++n) acc[a][b][m][n] = (f32x4){0.f, 0.f, 0.f, 0.f};
    bf16x8 At[4][2], B0[2][2], B1[2][2];
    const char* cA = (const char*)g.A + (size_t)cur.pm * tstep; const char* cB = (const char*)g.Bt + (size_t)cur.pb * tstep;
    S.a_ready(cur);
    if constexpr (SP2) {
        PG8_STAGE(PG8_SB(0, 0), cB, voffB); PG8_STAGE(PG8_SB(0, 1), cB + hstep, voffB); PG8_STAGE(PG8_SA(0, 0), cA, voffA); PG8_STAGE(PG8_SA(0, 1), cA + hstep, voffA);
        if (wr == 1) PG8_BAR;
        PG8_WAIT_V(2); PG8_BAR;
        PG8_STAGE(PG8_SB(1, 0), cB + kstep, voffB); PG8_STAGE(PG8_SA(1, 0), cA + kstep, voffA); PG8_STAGE(PG8_SB(1, 1), cB + hstep + kstep, voffB);
        PG8_WAIT_V(6); PG8_BAR;
    } else {
        PG8_STAGE(PG8_SB(0, 0), cB, voffB); PG8_STAGE(PG8_SA(0, 0), cA, voffA); PG8_STAGE(PG8_SB(0, 1), cB + hstep, voffB); PG8_STAGE(PG8_SA(0, 1), cA + hstep, voffA);
        if (wr == 1) PG8_BAR;
        PG8_WAIT_V(4); PG8_BAR;
        PG8_STAGE(PG8_SB(1, 0), cB + kstep, voffB); PG8_STAGE(PG8_SA(1, 0), cA + kstep, voffA); PG8_STAGE(PG8_SB(1, 1), cB + hstep + kstep, voffB);
        PG8_WAIT_V(6); PG8_BAR;
    }
    for (;;) {
        const bool has_next = S.next(ui + 1, nxt);
        const char* nA = has_next ? (const char*)g.A + (size_t)nxt.pm * tstep : cA; const char* nB = has_next ? (const char*)g.Bt + (size_t)nxt.pb * tstep : cB;
        for (int t = 0; t < nt; t += 2) {
            const bool last = (t == nt - 2);
            const char* a1 = cA + (size_t)(t + 1) * kstep;
            const char* a2 = last ? nA : cA + (size_t)(t + 2) * kstep; const char* b2 = last ? nB : cB + (size_t)(t + 2) * kstep;
            const char* a3 = a2 + kstep; const char* b3 = b2 + kstep;
            if (last && has_next) S.a_ready(nxt);
            if constexpr (SP2) {
            PG8_LDB(B0, 0, 0); PG8_LDB(B1, 0, 1); PG8_SCHED; PG8_LDA(At, 0, 0); PG8_STAGE(PG8_SA(1, 1), a1 + hstep, voffA);
            PG8_WAIT_V(8); PG8_WAIT_L(0); PG8_BAR; PG8_MMA(0, 0, At, B0); PG8_MMA(0, 1, At, B1); PG8_BAR; PG8_SCHED;
            PG8_LDA(At, 0, 1); PG8_STAGE(PG8_SB(0, 0), b2, voffB); PG8_STAGE(PG8_SB(0, 1), b2 + hstep, voffB); PG8_STAGE(PG8_SA(0, 0), a2, voffA);
            PG8_WAIT_V(8); PG8_WAIT_L(0); PG8_BAR; PG8_MMA(1, 0, At, B0); PG8_MMA(1, 1, At, B1); PG8_BAR; PG8_SCHED;
            PG8_LDB(B0, 1, 0); PG8_LDB(B1, 1, 1); PG8_SCHED; PG8_LDA(At, 1, 0); PG8_STAGE(PG8_SA(0, 1), a2 + hstep, voffA);
            PG8_WAIT_V(8); PG8_WAIT_L(0); PG8_BAR; PG8_MMA(0, 0, At, B0); PG8_MMA(0, 1, At, B1); PG8_BAR; PG8_SCHED;
            PG8_LDA(At, 1, 1); PG8_STAGE(PG8_SB(1, 0), b3, voffB); PG8_STAGE(PG8_SB(1, 1), b3 + hstep, voffB); PG8_STAGE(PG8_SA(1, 0), a3, voffA);
            PG8_WAIT_V(8); PG8_WAIT_L(0); PG8_BAR; PG8_MMA(1, 0, At, B0); PG8_MMA(1, 1, At, B1); PG8_BAR; PG8_SCHED;
            } else {
            PG8_LDB(B0, 0, 0); PG8_SCHED; PG8_LDA(At, 0, 0); PG8_STAGE(PG8_SA(1, 1), a1 + hstep, voffA);
            PG8_WAIT_L(8); PG8_BAR; PG8_WAIT_L(0); PG8_MMA(0, 0, At, B0); PG8_BAR; PG8_SCHED;
            PG8_LDB(B1, 0, 1); PG8_STAGE(PG8_SB(0, 0), b2, voffB);
            PG8_BAR; PG8_WAIT_L(0); PG8_MMA(0, 1, At, B1); PG8_BAR;
            PG8_LDA(At, 0, 1); PG8_STAGE(PG8_SA(0, 0), a2, voffA);
            PG8_BAR; PG8_WAIT_L(0); PG8_MMA(1, 0, At, B0); PG8_BAR; PG8_SCHED;
            PG8_STAGE(PG8_SB(0, 1), b2 + hstep, voffB);
            PG8_WAIT_V(6); PG8_BAR; PG8_MMA(1, 1, At, B1); PG8_BAR;
            PG8_LDB(B0, 1, 0); PG8_SCHED; PG8_LDA(At, 1, 0); PG8_STAGE(PG8_SA(0, 1), a2 + hstep, voffA);
            PG8_WAIT_L(8); PG8_BAR; PG8_WAIT_L(0); PG8_MMA(0, 0, At, B0); PG8_BAR; PG8_SCHED;
            PG8_LDB(B1, 1, 1); PG8_STAGE(PG8_SB(1, 0), b3, voffB);
            PG8_BAR; PG8_WAIT_L(0); PG8_MMA(0, 1, At, B1); PG8_BAR;
            PG8_LDA(At, 1, 1); PG8_STAGE(PG8_SA(1, 0), a3, voffA);
            PG8_BAR; PG8_WAIT_L(0); PG8_MMA(1, 0, At, B0); PG8_BAR; PG8_SCHED;
            PG8_STAGE(PG8_SB(1, 1), b3 + hstep, voffB);
            PG8_WAIT_V(6); PG8_BAR; PG8_MMA(1, 1, At, B1); PG8_BAR;
            }
        }
        if constexpr (ALIGN_EPI) { if (wr == 0) PG8_BAR; }
        if constexpr (!Epi::AFTER_DRAIN) { E(acc, cur, wr, wc, fr, fq); S.done(cur); }
        if (!has_next) break;
#pragma unroll
        for (int a = 0; a < 2; ++a)
#pragma unroll
            for (int b = 0; b < 2; ++b)
#pragma unroll
                for (int m = 0; m < 4; ++m)
#pragma unroll
                    for (int n = 0; n < 2; ++n) acc[a][b][m][n] = (f32x4){0.f, 0.f, 0.f, 0.f};
        cur = nxt; cA = nA; cB = nB; ++ui;
        if constexpr (ALIGN_EPI) { if (wr == 1) PG8_BAR; }
    }
    PG8_WAIT_V(0);
    if constexpr (!ALIGN_EPI) { if (wr == 0) PG8_BAR; }
    PG8_BAR;
    if constexpr (Epi::AFTER_DRAIN) { E.fused(acc, cur, wr, wc, fr, fq, lds, wid, lane); S.done(cur); }
#undef PG8_SA
#undef PG8_SB
#undef PG8_STAGE
#undef PG8_LDA
#undef PG8_LDB
#undef PG8_MMA
#undef PG8_WAIT_V
#undef PG8_WAIT_L
#undef PG8_BAR
#undef PG8_SCHED
}
}
#ifndef PG8_SP2
#define PG8_SP2 true
#endif
#ifndef PG8_ALIGN
#define PG8_ALIGN true
#endif
namespace pg8 {
struct EpiProj {
    static constexpr bool PERM = true, AFTER_DRAIN = false;
    bf16_t* O; int ldc; float qscale;
    __device__ __forceinline__ void operator()(const f32x4 (&acc)[2][2][4][2], const Unit& u, int wr, int wc, int fr, int fq) const {
        const int row0 = u.pm * BM + wr * 64 + fr, col0 = u.pn * BM + wc * 32 + 8 * fq;
        const float sc = (u.pn < 2 || u.pn == 6 || u.pn == 7) ? qscale : 1.f;
#pragma unroll
        for (int ai = 0; ai < 2; ++ai)
#pragma unroll
            for (int m = 0; m < 4; ++m) { bf16_t* rowp = O + (size_t)(row0 + ai * HALF + m * 16) * ldc + col0;
#pragma unroll
                for (int bj = 0; bj < 2; ++bj) { const f32x4 v0 = acc[ai][bj][m][0] * sc, v1 = acc[ai][bj][m][1] * sc;
                    u32x4 w; w.x = cvt_pk_bf16(v0[0], v0[1]); w.y = cvt_pk_bf16(v0[2], v0[3]); w.z = cvt_pk_bf16(v1[0], v1[1]); w.w = cvt_pk_bf16(v1[2], v1[3]);
                    *(u32x4*)(rowp + bj * HALF) = w; } }
    }
};
struct EpiSwiglu {
    static constexpr bool PERM = true, AFTER_DRAIN = false;
    bf16_t* O; const float* bias;
    __device__ __forceinline__ void operator()(const f32x4 (&acc)[2][2][4][2], const Unit& u, int wr, int wc, int fr, int fq) const {
        const int row0 = u.pm * BM + wr * 64 + fr, oc0 = u.pn * HALF + wc * 32 + 8 * fq;
        const float* bg = bias + (size_t)u.e * 2048 + oc0;
        const f32x4 g0 = *(const f32x4*)(bg), g1 = *(const f32x4*)(bg + 4), l0 = *(const f32x4*)(bg + 1024), l1 = *(const f32x4*)(bg + 1028);
#pragma unroll
        for (int ai = 0; ai < 2; ++ai)
#pragma unroll
            for (int m = 0; m < 4; ++m) { bf16_t* rowp = O + (size_t)(row0 + ai * HALF + m * 16) * 1024 + oc0;
                const f32x4 a0 = acc[ai][0][m][0] + g0, a1 = acc[ai][0][m][1] + g1, b0 = acc[ai][1][m][0] + l0, b1 = acc[ai][1][m][1] + l1;
                float r[8];
#pragma unroll
                for (int i = 0; i < 8; ++i) { const float xg = fminf(i < 4 ? a0[i & 3] : a1[i & 3], 7.0f); const float xl = fminf(fmaxf(i < 4 ? b0[i & 3] : b1[i & 3], -7.0f), 7.0f);
                    const float sg = __builtin_amdgcn_rcpf(1.0f + __builtin_amdgcn_exp2f(xg * (-1.702f * 1.4426950408889634f)));
                    r[i] = xg * sg * (xl + 1.0f); }
                u32x4 w; w.x = cvt_pk_bf16(r[0], r[1]); w.y = cvt_pk_bf16(r[2], r[3]); w.z = cvt_pk_bf16(r[4], r[5]); w.w = cvt_pk_bf16(r[6], r[7]);
                *(u32x4*)(rowp) = w; }
    }
};
struct EpiDown {
    static constexpr bool PERM = true, AFTER_DRAIN = false;
    bf16_t* O; const float* bias; const float* rowgate;
    __device__ __forceinline__ void operator()(const f32x4 (&acc)[2][2][4][2], const Unit& u, int wr, int wc, int fr, int fq) const {
        const int row0 = u.pm * BM + wr * 64 + fr, col0 = u.pn * BM + wc * 32 + 8 * fq;
        const float* bp = bias + (size_t)u.e * 1024 + col0;
        f32x4 bv[2][2];
#pragma unroll
        for (int bj = 0; bj < 2; ++bj)
#pragma unroll
            for (int n = 0; n < 2; ++n) bv[bj][n] = *(const f32x4*)(bp + bj * HALF + 4 * n);
#pragma unroll
        for (int ai = 0; ai < 2; ++ai)
#pragma unroll
            for (int m = 0; m < 4; ++m) { const int row = row0 + ai * HALF + m * 16; const float g = rowgate[row]; bf16_t* rowp = O + (size_t)row * 1024 + col0;
#pragma unroll
                for (int bj = 0; bj < 2; ++bj) { const f32x4 v0 = (acc[ai][bj][m][0] + bv[bj][0]) * g, v1 = (acc[ai][bj][m][1] + bv[bj][1]) * g;
                    u32x4 w; w.x = cvt_pk_bf16(v0[0], v0[1]); w.y = cvt_pk_bf16(v0[2], v0[3]); w.z = cvt_pk_bf16(v1[0], v1[1]); w.w = cvt_pk_bf16(v1[2], v1[3]);
                    *(u32x4*)(rowp + bj * HALF) = w; } }
    }
};
struct MoeSched {
    const PG8_LAS int* tileE; int T, NC, x, r, per, groups;
    __device__ __forceinline__ bool next(int i, Unit& u) const {
        const int lo = x * T / groups, hi = (x + 1) * T / groups, ul = i * per + r;
        if (ul >= (hi - lo) * NC) return false;
        const int tile = lo + ul / NC, pn = ul % NC, e = __builtin_amdgcn_readfirstlane(tileE[tile]);
        u.pm = tile; u.pn = pn; u.pb = e * NC + pn; u.e = e; return true;
    }
    __device__ __forceinline__ void a_ready(const Unit&) const {}
    __device__ __forceinline__ void done(const Unit&) const {}
};
}
namespace attn_body {
using bf16=__hip_bfloat16;
using bf16x8=__attribute__((ext_vector_type(8)))short;
using s16x4=__attribute__((ext_vector_type(4)))short;
using f32x16=__attribute__((ext_vector_type(16)))float;
using u32x4=__attribute__((ext_vector_type(4)))unsigned;
__device__ __forceinline__ int crow(int r,int hi){return (r&3)+8*(r>>2)+4*hi;}
#define SBAR() __builtin_amdgcn_sched_barrier(0)
__device__ __forceinline__ void cmask(f32x16&p0,f32x16&p1,int jb,int qrel,int hi){
  const float NEG=-INFINITY; int kb=64*jb+4*hi;
  #pragma unroll
  for(int r=0;r<16;++r){int kv=kb+(r&3)+8*(r>>2); if(kv>qrel)p0[r]=NEG; if(kv+32>qrel)p1[r]=NEG;}
}
__device__ __forceinline__ void glds16(const void*gsrc,unsigned lds_dst){unsigned keep;
  asm volatile("s_mov_b32 %0, m0\n\ts_mov_b32 m0, %2\n\ts_nop 0\n\tglobal_load_lds_dwordx4 %1, off\n\ts_mov_b32 m0, %0":"=&s"(keep):"v"(gsrc),"s"(lds_dst):"memory");}
__device__ __forceinline__ float max3f(float a,float b,float c){float r;asm("v_max3_f32 %0, %1, %2, %3":"=v"(r):"v"(a),"v"(b),"v"(c));return r;}
__device__ __forceinline__ float max2f(float a,float b){float r;asm("v_max_f32_e32 %0, %1, %2":"=v"(r):"v"(a),"v"(b));return r;}
__device__ __forceinline__ float fadd_s(float a,float b){float r;asm("v_add_f32_e32 %0, %1, %2":"=v"(r):"v"(a),"v"(b));return r;}
__device__ __forceinline__ float fsub_s(float a,float b){float r;asm("v_sub_f32_e32 %0, %1, %2":"=v"(r):"v"(a),"v"(b));return r;}
typedef float f32x2_t __attribute__((ext_vector_type(2))); typedef __bf16 bf16x2_t __attribute__((ext_vector_type(2)));
__device__ __forceinline__ unsigned cvtpk_s(float lo,float hi){f32x2_t v={lo,hi};bf16x2_t b=__builtin_convertvector(v,bf16x2_t);return __builtin_bit_cast(unsigned,b);}
__device__ __forceinline__ float rowmax(const f32x16&p0,const f32x16&p1){
  float a=max3f(p0[0],p0[1],p1[0]),b=max3f(p0[2],p0[3],p1[1]);a=max3f(a,p1[2],p1[3]);
  #pragma unroll
  for(int r=4;r<16;r+=4){a=max3f(a,p0[r],p0[r+1]);b=max3f(b,p0[r+2],p0[r+3]);a=max3f(a,p1[r],p1[r+1]);b=max3f(b,p1[r+2],p1[r+3]);}
  const float m=max2f(a,b);
  auto rr=__builtin_amdgcn_permlane32_swap(__float_as_uint(m),__float_as_uint(m),false,false);
  return max2f(__uint_as_float(rr[0]),__uint_as_float(rr[1]));
}
__device__ __forceinline__ void pv(f32x16*o,int vb,bf16x8 pa0,bf16x8 pa1,bf16x8 pa2,bf16x8 pa3){
  #pragma unroll
  for(int d0=0;d0<2;++d0){s16x4 lo[4],hi[4];
    #pragma unroll
    for(int ks=0;ks<4;++ks){
      asm volatile("ds_read_b64_tr_b16 %0,%1 offset:%c2":"=&v"(lo[ks]):"v"(vb),"i"(d0*4096+ks*1024):"memory");
      asm volatile("ds_read_b64_tr_b16 %0,%1 offset:%c2":"=&v"(hi[ks]):"v"(vb),"i"(d0*4096+ks*1024+512):"memory");}
    asm volatile("s_waitcnt lgkmcnt(0)":::"memory");SBAR();
    #define PK(k) (bf16x8){lo[k][0],lo[k][1],lo[k][2],lo[k][3],hi[k][0],hi[k][1],hi[k][2],hi[k][3]}
    o[d0]=__builtin_amdgcn_mfma_f32_32x32x16_bf16(pa0,PK(0),o[d0],0,0,0);
    o[d0]=__builtin_amdgcn_mfma_f32_32x32x16_bf16(pa1,PK(1),o[d0],0,0,0);
    o[d0]=__builtin_amdgcn_mfma_f32_32x32x16_bf16(pa2,PK(2),o[d0],0,0,0);
    o[d0]=__builtin_amdgcn_mfma_f32_32x32x16_bf16(pa3,PK(3),o[d0],0,0,0);
    #undef PK
  }
}
#undef SBAR
}
#define GAS __attribute__((address_space(1)))
#define LAS __attribute__((address_space(3)))
typedef unsigned short bf16;
typedef unsigned v4u __attribute__((ext_vector_type(4)));
typedef float f32x4 __attribute__((ext_vector_type(4)));
typedef short bf16x8 __attribute__((ext_vector_type(8)));
typedef GAS unsigned gu32;
typedef GAS unsigned long long gu64;
#define RLX_AGENT __ATOMIC_RELAXED, __HIP_MEMORY_SCOPE_AGENT
#define LDS_WAIT() asm volatile("s_waitcnt lgkmcnt(0)" ::: "memory")
#define VM_WAIT() asm volatile("s_waitcnt vmcnt(0)" ::: "memory")
__device__ __forceinline__ unsigned long long rt() { return __builtin_amdgcn_s_memrealtime(); }
__device__ __forceinline__ unsigned f2bf(float f) { unsigned u = __builtin_bit_cast(unsigned, f); return (u + 0x7fffu + ((u >> 16) & 1u)) >> 16; }
__device__ __forceinline__ unsigned pk2(float lo, float hi) { return f2bf(lo) | (f2bf(hi) << 16); }

#define XB_TMO      128
#define XB_XCNT(j)  (256  + 64 * (j))
#define XB_XSUB(j)  (1280 + 64 * (j))
#define XB_XGEN(j)  (2304 + 64 * (j))
#define XB_TOP      3328
#define XB_TOPGEN   3392
#define XCD_BAR_WORDS 3456
#define XB_SPIN_CAP (1u << 18)

__device__ __forceinline__ unsigned xb_ld(unsigned* p)              { return __hip_atomic_load(p, __ATOMIC_RELAXED, __HIP_MEMORY_SCOPE_AGENT); }
__device__ __forceinline__ unsigned xb_add(unsigned* p, unsigned v) { return __hip_atomic_fetch_add(p, v, __ATOMIC_RELAXED, __HIP_MEMORY_SCOPE_AGENT); }
__device__ __forceinline__ unsigned xb_xcc_id() { return (unsigned)__builtin_amdgcn_s_getreg((3 << 11) | 20) & 0xFu; }
#define XB_SPIN(cond, bar) do { unsigned _sp = 0; while (cond) { __builtin_amdgcn_s_sleep(1); \
    if ((++_sp & 255u) == 0u) { if (xb_ld(&(bar)[XB_TMO])) break; if (_sp > XB_SPIN_CAP) { atomicAdd(&(bar)[XB_TMO], 1u); break; } } } } while (0)

struct XcdBarrier {
    unsigned* bar; unsigned x;
    volatile LAS unsigned* st;
};

__device__ __forceinline__ XcdBarrier xcd_barrier_post(unsigned* bar, volatile LAS unsigned* st) {
    XcdBarrier b; b.bar = bar; b.x = xb_xcc_id(); b.st = st;
    if (threadIdx.x == 0) (void)xb_add(&bar[XB_XCNT(b.x)], 1u);
    return b;
}
__device__ __forceinline__ void xcd_barrier_complete(unsigned* bar, unsigned x, unsigned& nloc, unsigned& nx) {
    const unsigned G = gridDim.x * gridDim.y * gridDim.z;
    unsigned sum, cnt, mine, sp = 0u;
    for (;;) {
        sum = 0u; cnt = 0u; mine = 0u;
#pragma unroll
        for (unsigned j = 0; j < 16; ++j) { const unsigned c = xb_ld(&bar[XB_XCNT(j)]); sum += c; cnt += (c > 0u) ? 1u : 0u; mine = (j == x) ? c : mine; }
        if (sum == G) break;
        __builtin_amdgcn_s_sleep(1);
        if ((++sp & 255u) == 0u) { if (xb_ld(&bar[XB_TMO])) break; if (sp > XB_SPIN_CAP) { atomicAdd(&bar[XB_TMO], 1u); break; } }
    }
    nloc = mine > 0u ? mine : 1u; nx = cnt > 0u ? cnt : 1u;
}

__device__ __forceinline__ void xcd_barrier(const XcdBarrier& b) {
    asm volatile("s_waitcnt vmcnt(0)" ::: "memory");
    __syncthreads();
    if (threadIdx.x == 0) {
        unsigned* bar = b.bar;
        __builtin_amdgcn_s_waitcnt(0);
        unsigned nloc = b.st[0], nx = b.st[1];
        if (nloc == 0u) { xcd_barrier_complete(bar, b.x, nloc, nx); b.st[0] = nloc; b.st[1] = nx; }
        const unsigned old = xb_add(&bar[XB_XSUB(b.x)], 1u);
        const unsigned gen = old / nloc;
        if (old + 1u == (gen + 1u) * nloc) {
            __builtin_amdgcn_fence(__ATOMIC_RELEASE, "agent");
            asm volatile("s_waitcnt vmcnt(0)" ::: "memory");
            const unsigned og = xb_add(&bar[XB_TOP], 1u);
            const unsigned tg = og / nx;
            if (og + 1u == (tg + 1u) * nx) xb_add(&bar[XB_TOPGEN], 1u);
            else XB_SPIN(xb_ld(&bar[XB_TOPGEN]) == tg, bar);
            __builtin_amdgcn_fence(__ATOMIC_ACQUIRE, "agent");
            xb_add(&bar[XB_XGEN(b.x)], 1u);
            asm volatile("s_waitcnt vmcnt(0)" ::: "memory");
        } else {
            XB_SPIN(xb_ld(&bar[XB_XGEN(b.x)]) == gen, bar);
            __builtin_amdgcn_fence(__ATOMIC_ACQUIRE, "agent");
            asm volatile("s_waitcnt vmcnt(0)" ::: "memory");
        }
    }
    __syncthreads();
}
namespace ab = attn_body;
using ab::f32x16;
typedef unsigned u32x4 __attribute__((ext_vector_type(4)));
typedef unsigned u32x2 __attribute__((ext_vector_type(2)));

constexpr int NWAVES = 8;
constexpr int SEQ = 16384, DM = 1024, NH = 8, HD = 64, PITCH = 3072, INW = 3080;
constexpr int NE = 32, TOPK = 4;
constexpr int NCHUNK = 256, CHR = 64;
constexpr int NMB = 64;
constexpr int RMAX = 65536 + 32 * 256, TMAX = RMAX / 256;
constexpr float RMS_EPS = 1e-6f, LOG2E = 1.4426950408889634f, C2 = 0.125f * 1.4426950408889634f;
constexpr int LCAP = 256 * 2016;
constexpr int OFF_QA = 0, OFF_KA = 512, OFF_VA = 1024, OFF_QB = 1536, OFF_KB = 2048, OFF_VB = 2560;

constexpr size_t MiB = 1u << 20;
constexpr size_t WS_CTL = 0, CTL_ZERO_BYTES = 1 * MiB;
constexpr size_t WS_MOD = 1 * MiB, WS_TOT = WS_MOD + 65536, WS_KNMAX = WS_MOD + 131072, WS_QNMAX = WS_MOD + 196608;
constexpr size_t WS_LOGF = 2 * MiB, WS_CUM = 2 * MiB + 524288, WS_KSUM = 3 * MiB;
constexpr size_t WS_WTOUT = 4 * MiB, WS_WTIN = 6 * MiB;
constexpr size_t WS_EIDX = 12 * MiB, WS_GATE = WS_EIDX + 262144, WS_LOC = WS_GATE + 262144, WS_POS = WS_LOC + 262144;
constexpr size_t WS_ROWGATE = 13 * MiB, WS_PM = 14 * MiB, WS_PL = 16 * MiB, WS_MLIST = 18 * MiB;
constexpr size_t WS_XN = 34 * MiB, WS_PROJ = 66 * MiB, WS_MIX = 162 * MiB, WS_AO = 194 * MiB, WS_PO = 226 * MiB;
constexpr size_t WS_WTGU = 290 * MiB, WS_WTDN = 418 * MiB, WS_ROWS = 482 * MiB, WS_ACT = 626 * MiB, WS_Y = 770 * MiB, WS_END = 914 * MiB;
static_assert((size_t)NH * LCAP * 4 <= 16 * MiB && (size_t)RMAX * 1024 * 2 == 144 * MiB, "d_ws map");
constexpr int CW_BAR = 4096;
constexpr int CW_GCNT = 32768;
constexpr int CW_ECNT = 40960;

constexpr int RING_BYTES = 131072;
constexpr int MISC_OFF = RING_BYTES;
constexpr int X_OFF = RING_BYTES + 256;
constexpr int LDS_BYTES = 147456;
constexpr int A_K = 0, A_V = 32768, A_LUT = 65536, A_WS = 81920, A_BIAS = 83968, A_OST = 84224, A_PFX = 116992;

struct Args { const float* in[18]; float* out; unsigned char* ws; int ph_lo, ph_hi; };
struct Frame { LAS unsigned char* lds; gu32* ctl; int tid, lane, wave, G, bid; };

__device__ __forceinline__ float bf2f(unsigned short b) { return __uint_as_float((unsigned)b << 16); }
__device__ __forceinline__ float wave_sum(float v) {
#pragma unroll
    for (int o = 1; o < 64; o <<= 1) v += __shfl_xor(v, o);
    return v;
}
__device__ __forceinline__ float wave_max(float v) {
#pragma unroll
    for (int o = 1; o < 64; o <<= 1) v = fmaxf(v, __shfl_xor(v, o));
    return v;
}
__device__ __forceinline__ double wave_sum_d(double v) {
#pragma unroll
    for (int o = 1; o < 64; o <<= 1) { const int lo = __shfl_xor(__double2loint(v), o), hi = __shfl_xor(__double2hiint(v), o); v += __hiloint2double(hi, lo); }
    return v;
}
__device__ __forceinline__ unsigned lds_addr(LAS const void* p) { return (unsigned)(uintptr_t)p; }
__device__ __forceinline__ int t5_bucket(int d) {
    if (d < 16) return d;
    int b = 16;
    b += (d >= 19); b += (d >= 21); b += (d >= 24); b += (d >= 27); b += (d >= 31); b += (d >= 35); b += (d >= 40); b += (d >= 46);
    b += (d >= 52); b += (d >= 59); b += (d >= 67); b += (d >= 77); b += (d >= 87); b += (d >= 99); b += (d >= 113);
    return b;
}

struct CvtItem { const float* src; bf16* dst; int ldn; };
__device__ __forceinline__ CvtItem cvt_decode(const Args& a, int it) {
    CvtItem c;
    if (it < 384) { const int ng = it >> 3, kg = it & 7; c.src = a.in[6] + (size_t)(kg * 128) * INW + ng * 64; c.ldn = INW; c.dst = (bf16*)(a.ws + WS_WTIN) + (size_t)(ng * 64) * 1024 + kg * 128; return c; }
    it -= 384;
    if (it < 128) { const int ng = it >> 3, kg = it & 7; c.src = a.in[9] + (size_t)(kg * 128) * 1024 + ng * 64; c.ldn = 1024; c.dst = (bf16*)(a.ws + WS_WTOUT) + (size_t)(ng * 64) * 1024 + kg * 128; return c; }
    it -= 128;
    if (it < 8192) { const int e = it >> 8, rem = it & 255, ng = rem >> 3, kg = rem & 7, c0 = ng * 64;
        const int drow = (c0 < 1024) ? (c0 >> 7) * 256 + (c0 & 127) : ((c0 - 1024) >> 7) * 256 + 128 + ((c0 - 1024) & 127);
        c.src = a.in[14] + (size_t)e * 1024 * 2048 + (size_t)(kg * 128) * 2048 + c0; c.ldn = 2048; c.dst = (bf16*)(a.ws + WS_WTGU) + (size_t)(e * 2048 + drow) * 1024 + kg * 128; return c; }
    it -= 8192;
    { const int e = it >> 7, rem = it & 127, ng = rem >> 3, kg = rem & 7;
      c.src = a.in[16] + (size_t)e * 1024 * 1024 + (size_t)(kg * 128) * 1024 + ng * 64; c.ldn = 1024; c.dst = (bf16*)(a.ws + WS_WTDN) + (size_t)(e * 1024 + ng * 64) * 1024 + kg * 128; return c; }
}
__device__ __forceinline__ void phase0(const Args& a, Frame& F) {
    float* mod = (float*)(a.ws + WS_MOD);
    {
        LAS float* red = (LAS float*)F.lds;
        const float* cvec = a.in[1]; const float* W = a.in[2];
        for (int cb = F.bid; cb < 192; cb += F.G) {
            const int col = cb * 32 + (F.lane & 31), kh = F.lane >> 5;
            float acc = 0.f;
#pragma unroll 8
            for (int i = 0; i < 64; ++i) { const int k = F.wave * 128 + 2 * i + kh; const float cv = cvec[k]; const float s = cv / (1.0f + __expf(-cv)); acc += s * W[(size_t)k * 6144 + col]; }
            acc += __shfl_xor(acc, 32);
            if (F.lane < 32) red[F.wave * 32 + F.lane] = acc;
            __syncthreads();
            if (F.tid < 32) { float s = 0.f;
#pragma unroll
                for (int w = 0; w < 8; ++w) s += red[w * 32 + F.tid];
                mod[cb * 32 + F.tid] = s + a.in[3][cb * 32 + F.tid]; }
            __syncthreads();
        }
    }
    {
        LAS float* scr = (LAS float*)F.lds;
        constexpr int NITEMS = 384 + 128 + 8192 + 4096;
        const int n4 = (F.tid & 15) * 4, kr = F.tid >> 4, kg8 = F.tid & 15, nn = F.tid >> 4;
        int it = F.bid; f32x4 v[4]; CvtItem cur;
        if (it < NITEMS) { cur = cvt_decode(a, it);
#pragma unroll
            for (int p = 0; p < 4; ++p) v[p] = *(const f32x4*)(cur.src + (size_t)(kr + 32 * p) * cur.ldn + n4); }
        while (it < NITEMS) {
            __syncthreads();
#pragma unroll
            for (int p = 0; p < 4; ++p) { LAS float* s = scr + (kr + 32 * p) * 65 + n4; s[0] = v[p][0]; s[1] = v[p][1]; s[2] = v[p][2]; s[3] = v[p][3]; }
            __syncthreads();
            bf16* dst = cur.dst;
            const int nx = it + F.G;
            if (nx < NITEMS) { cur = cvt_decode(a, nx);
#pragma unroll
                for (int p = 0; p < 4; ++p) v[p] = *(const f32x4*)(cur.src + (size_t)(kr + 32 * p) * cur.ldn + n4); }
#pragma unroll
            for (int q = 0; q < 2; ++q) { const int n = nn + 32 * q; const LAS float* s = scr + (8 * kg8) * 65 + n;
                u32x4 o; o.x = ab::cvtpk_s(s[0], s[65]); o.y = ab::cvtpk_s(s[130], s[195]); o.z = ab::cvtpk_s(s[260], s[325]); o.w = ab::cvtpk_s(s[390], s[455]);
                *(u32x4*)(dst + (size_t)n * 1024 + 8 * kg8) = o; }
            it = nx;
        }
        __syncthreads();
    }
}

__device__ __forceinline__ void phase1(const Args& a, Frame& F) {
    const float* mod = (const float*)(a.ws + WS_MOD);
    LAS float* wfT = (LAS float*)F.lds;
    LAS float* totw = (LAS float*)(F.lds + 32768);
    for (int col = F.tid; col < 1024; col += NWAVES * 64) { const float* p = a.in[6] + (size_t)col * INW + 3072; const f32x4 u = *(const f32x4*)p, w = *(const f32x4*)(p + 4);
        wfT[0 * 1024 + col] = u[0]; wfT[1 * 1024 + col] = u[1]; wfT[2 * 1024 + col] = u[2]; wfT[3 * 1024 + col] = u[3];
        wfT[4 * 1024 + col] = w[0]; wfT[5 * 1024 + col] = w[1]; wfT[6 * 1024 + col] = w[2]; wfT[7 * 1024 + col] = w[3]; }
    f32x4 A[4], B[4];
#pragma unroll
    for (int j = 0; j < 4; ++j) { const int c = 256 * j + 4 * F.lane; const f32x4 g = *(const f32x4*)(a.in[4] + c), sc = *(const f32x4*)(mod + 1024 + c); A[j] = g * (sc + 1.0f); B[j] = *(const f32x4*)(mod + c); }
    const float bfg = a.in[7][F.lane & 7];
    __syncthreads();
    bf16* XN = (bf16*)(a.ws + WS_XN); float* LOGF = (float*)(a.ws + WS_LOGF); float* TOT = (float*)(a.ws + WS_TOT);
    for (int c = F.bid; c < NCHUNK; c += F.G) {
        float tot = 0.f;
        for (int rr = 0; rr < 8; ++rr) {
            const int row = c * CHR + F.wave * 8 + rr;
            const float* xr = a.in[0] + (size_t)row * DM + 4 * F.lane;
            f32x4 v[4]; float ss = 0.f;
#pragma unroll
            for (int j = 0; j < 4; ++j) { v[j] = *(const f32x4*)(xr + 256 * j); ss += (v[j][0] * v[j][0] + v[j][1] * v[j][1]) + (v[j][2] * v[j][2] + v[j][3] * v[j][3]); }
            const float rstd = 1.0f / sqrtf(wave_sum(ss) * (1.0f / DM) + RMS_EPS);
            bf16* orow = XN + (size_t)row * DM + 4 * F.lane;
#pragma unroll
            for (int j = 0; j < 4; ++j) { v[j] = (v[j] * rstd) * A[j] + B[j]; u32x2 o; o.x = ab::cvtpk_s(v[j][0], v[j][1]); o.y = ab::cvtpk_s(v[j][2], v[j][3]); *(u32x2*)(orow + 256 * j) = o; }
            float pe[8];
#pragma unroll
            for (int e = 0; e < 8; ++e) { float s = 0.f;
#pragma unroll
                for (int j = 0; j < 4; ++j) { const f32x4 w = *(const LAS f32x4*)(wfT + e * 1024 + 256 * j + 4 * F.lane); s += (v[j][0] * w[0] + v[j][1] * w[1]) + (v[j][2] * w[2] + v[j][3] * w[3]); }
                pe[e] = wave_sum(s); }
            const int e = F.lane & 7;
            float z = pe[0]; z = e == 1 ? pe[1] : z; z = e == 2 ? pe[2] : z; z = e == 3 ? pe[3] : z; z = e == 4 ? pe[4] : z; z = e == 5 ? pe[5] : z; z = e == 6 ? pe[6] : z; z = e == 7 ? pe[7] : z;
            z += bfg;
            const float lf = fminf(z, 0.f) - log1pf(expf(-fabsf(z)));
            if (F.lane < 8) { LOGF[(size_t)row * 8 + F.lane] = lf; tot += lf; }
        }
        if (F.lane < 8) totw[F.wave * 8 + F.lane] = tot;
        __syncthreads();
        if (F.tid < 8) { float s = 0.f;
#pragma unroll
            for (int w = 0; w < 8; ++w) s += totw[w * 8 + F.tid];
            TOT[c * 8 + F.tid] = s; }
        __syncthreads();
    }
}

__device__ __forceinline__ float sumsq8(u32x4 v) {
    float s = 0.f;
#pragma unroll
    for (int i = 0; i < 4; ++i) { const float lo = __uint_as_float(v[i] << 16), hi = __uint_as_float(v[i] & 0xffff0000u); s += lo * lo + hi * hi; }
    return s;
}
__device__ __forceinline__ void phase3(const Args& a, Frame& F) {
    const float* LOGF = (const float*)(a.ws + WS_LOGF); const float* TOT = (const float*)(a.ws + WS_TOT);
    float* CUM = (float*)(a.ws + WS_CUM); float* KSUM = (float*)(a.ws + WS_KSUM);
    float* KNMAX = (float*)(a.ws + WS_KNMAX); float* QNMAX = (float*)(a.ws + WS_QNMAX);
    const bf16* P = (const bf16*)(a.ws + WS_PROJ);
    LAS float* redk = (LAS float*)F.lds; LAS float* redq = redk + 64;
    for (int c = F.bid; c < NCHUNK; c += F.G) {
        if (F.wave == 0) {
            for (int h = 0; h < NH; ++h) {
                double s = 0.0;
#pragma unroll
                for (int i = 0; i < 4; ++i) { const int cc = F.lane + 64 * i; if (cc < c) s += (double)TOT[cc * 8 + h]; }
                s = wave_sum_d(s);
                float x = LOGF[(size_t)(c * CHR + F.lane) * 8 + h];
#pragma unroll
                for (int o = 1; o < 64; o <<= 1) { const float y = __shfl_up(x, o); if (F.lane >= o) x += y; }
                CUM[(size_t)(c * CHR + F.lane) * 8 + h] = (float)(s + (double)x);
            }
        }
        { float s = 0.f; const bf16* p = P + (size_t)(c * CHR) * PITCH + OFF_KB + F.tid;
#pragma unroll 8
          for (int r = 0; r < CHR; ++r) s += bf2f(p[(size_t)r * PITCH]);
          KSUM[c * 512 + F.tid] = s; }
        { float kmx = 0.f, qmx = 0.f;
          for (int rr = 0; rr < 8; ++rr) { const size_t row = (size_t)(c * CHR + F.wave * 8 + rr);
              const u32x4 kv = *(const u32x4*)(P + row * PITCH + OFF_KA + 8 * F.lane), qv = *(const u32x4*)(P + row * PITCH + OFF_QA + 8 * F.lane);
              float sk = sumsq8(kv), sq = sumsq8(qv);
              sk += __shfl_xor(sk, 1); sk += __shfl_xor(sk, 2); sk += __shfl_xor(sk, 4);
              sq += __shfl_xor(sq, 1); sq += __shfl_xor(sq, 2); sq += __shfl_xor(sq, 4);
              kmx = fmaxf(kmx, sk); qmx = fmaxf(qmx, sq); }
          if ((F.lane & 7) == 0) { redk[F.wave * 8 + (F.lane >> 3)] = kmx; redq[F.wave * 8 + (F.lane >> 3)] = qmx; }
          __syncthreads();
          if (F.tid < 8) { float k = 0.f, q = 0.f;
#pragma unroll
              for (int w = 0; w < 8; ++w) { k = fmaxf(k, redk[w * 8 + F.tid]); q = fmaxf(q, redq[w * 8 + F.tid]); }
              KNMAX[c * 8 + F.tid] = k; QNMAX[c * 8 + F.tid] = q; }
          __syncthreads(); }
    }
}

__device__ __forceinline__ void qkt2(f32x16& p0, f32x16& p1, LAS const unsigned char* kslot, const bf16x8* qr, const f32x16& c0, const f32x16& c1, int r32, int hi) {
    LAS const unsigned char* kb = kslot + hi * 1024 + r32 * 16;
#pragma unroll
    for (int d0 = 0; d0 < 4; ++d0) {
        const bf16x8 b0 = *(LAS const bf16x8*)(kb + d0 * 2048), b1 = *(LAS const bf16x8*)(kb + d0 * 2048 + 512);
        if (d0 == 0) { p0 = __builtin_amdgcn_mfma_f32_32x32x16_bf16(b0, qr[0], c0, 0, 0, 0); p1 = __builtin_amdgcn_mfma_f32_32x32x16_bf16(b1, qr[0], c1, 0, 0, 0); }
        else { p0 = __builtin_amdgcn_mfma_f32_32x32x16_bf16(b0, qr[d0], p0, 0, 0, 0); p1 = __builtin_amdgcn_mfma_f32_32x32x16_bf16(b1, qr[d0], p1, 0, 0, 0); }
    }
}
__device__ __forceinline__ void softmax_pv(f32x16& p0, f32x16& p1, float& m, float& l, f32x16 (&o)[2], LAS float* wsf, int vb, int r32, int hi) {
    const float rm = ab::rowmax(p0, p1);
    const float mn = fmaxf(m, rm);
    const float f = __builtin_amdgcn_exp2f(m - mn);
    m = mn; l *= f;
    asm volatile("" ::: "memory");
    if (hi == 0) wsf[r32] = f;
    asm volatile("" ::: "memory");
#pragma unroll
    for (int g = 0; g < 4; ++g) { const f32x4 fr = *(LAS const f32x4*)(wsf + 8 * g + 4 * hi);
#pragma unroll
        for (int k = 0; k < 4; ++k) { o[0][4 * g + k] *= fr[k]; o[1][4 * g + k] *= fr[k]; } }
    asm volatile("" ::: "memory");
    float s = 0.f;
#pragma unroll
    for (int r = 0; r < 16; ++r) { p0[r] = __builtin_amdgcn_exp2f(p0[r] - m); p1[r] = __builtin_amdgcn_exp2f(p1[r] - m); s += p0[r] + p1[r]; }
    l += s;
    u32x4 pw0, pw1, pw2, pw3;
    pw0 = (u32x4){ab::cvtpk_s(p0[0], p0[1]), ab::cvtpk_s(p0[2], p0[3]), ab::cvtpk_s(p0[4], p0[5]), ab::cvtpk_s(p0[6], p0[7])};
    pw1 = (u32x4){ab::cvtpk_s(p0[8], p0[9]), ab::cvtpk_s(p0[10], p0[11]), ab::cvtpk_s(p0[12], p0[13]), ab::cvtpk_s(p0[14], p0[15])};
    pw2 = (u32x4){ab::cvtpk_s(p1[0], p1[1]), ab::cvtpk_s(p1[2], p1[3]), ab::cvtpk_s(p1[4], p1[5]), ab::cvtpk_s(p1[6], p1[7])};
    pw3 = (u32x4){ab::cvtpk_s(p1[8], p1[9]), ab::cvtpk_s(p1[10], p1[11]), ab::cvtpk_s(p1[12], p1[13]), ab::cvtpk_s(p1[14], p1[15])};
    __builtin_amdgcn_sched_barrier(0);
    ab::pv(o, vb, __builtin_bit_cast(bf16x8, pw0), __builtin_bit_cast(bf16x8, pw1), __builtin_bit_cast(bf16x8, pw2), __builtin_bit_cast(bf16x8, pw3));
}
__device__ __forceinline__ void stage_o(const f32x16 (&o)[2], const float (&rli)[16], LAS bf16* stg, int r32, int hi) {
#pragma unroll
    for (int r = 0; r < 16; ++r) { const int orow = ab::crow(r, hi);
#pragma unroll
        for (int d0 = 0; d0 < 2; ++d0) stg[orow * 64 + d0 * 32 + r32] = (bf16)(ab::cvtpk_s(o[d0][r] * rli[r], 0.f) & 0xffffu); }
}

__device__ __forceinline__ void fox_unit(const Args& a, Frame& F, int h, int qb) {
    const bf16* P = (const bf16*)(a.ws + WS_PROJ); const float* CUM = (const float*)(a.ws + WS_CUM);
    const float* KNMAX = (const float*)(a.ws + WS_KNMAX); const float* QNMAX = (const float*)(a.ws + WS_QNMAX);
    const int lane = F.lane, r32 = lane & 31, hi = lane >> 5, wid = F.wave, t0 = qb * 256;
    float qn = 0.f, kn = 0.f;
    if (lane < 4) qn = QNMAX[(4 * qb + lane) * 8 + h];
#pragma unroll
    for (int i = 0; i < 4; ++i) kn = fmaxf(kn, KNMAX[(lane + 64 * i) * 8 + h]);
    qn = wave_max(qn); kn = wave_max(kn);
    const float bnd = 2.0f * sqrtf(qn) * sqrtf(kn) * 1.001f + 0.05f;
    const float Ct0 = CUM[(size_t)t0 * 8 + h], Cref = CUM[(size_t)(t0 + 255) * 8 + h];
    int jmin = 0; bool found = false;
    for (int base = 4 * qb - 1; base >= 0 && !found; base -= 64) {
        const int j = base - lane; bool need = false;
        if (j >= 0) need = (bnd + (Ct0 - CUM[(size_t)(64 * j + 63) * 8 + h]) * LOG2E) >= -44.5f;
        const unsigned long long mk = __ballot(need);
        if (mk == 0ull) { jmin = base + 1; found = true; }
        else { const int hb = 63 - __builtin_clzll(mk); if (hb < 63) { jmin = base - hb; found = true; } }
    }
    jmin = __builtin_amdgcn_readfirstlane(jmin);
    const int NT = 4 * qb + 4;
    const bf16* Qw = P + (size_t)(t0 + wid * 32 + r32) * PITCH + OFF_QA + h * 64;
    bf16x8 qr[4];
#pragma unroll
    for (int d0 = 0; d0 < 4; ++d0) qr[d0] = *(const bf16x8*)(Qw + d0 * 16 + hi * 8);
    float m = -1e30f, l = 0.f; f32x16 o[2]; o[0] = f32x16{}; o[1] = f32x16{};
    const bf16* ksrc = P + OFF_KA + h * 64 + (size_t)lane * PITCH + wid * 8;
    const bf16* vsrc = P + OFF_VA + h * 64 + (size_t)(16 * (wid & 3) + (lane >> 2)) * PITCH + (wid >> 2) * 32 + (lane & 3) * 8;
    const unsigned kdst = lds_addr(F.lds + A_K) + wid * 1024, vdst = lds_addr(F.lds + A_V) + wid * 1024;
    LAS float* bias = (LAS float*)(F.lds + A_BIAS); LAS float* wsf = (LAS float*)(F.lds + A_WS) + wid * 64;
    const int vb = (int)lds_addr(F.lds + A_V) + ((lane >> 4) & 1) * 32 + (lane & 3) * 8 + (4 * hi + ((lane & 15) >> 2)) * 64;
    for (int j = jmin; j < NT; ++j) {
        __syncthreads();
        ab::glds16(ksrc + (size_t)j * 64 * PITCH, (unsigned)__builtin_amdgcn_readfirstlane(kdst));
        ab::glds16(vsrc + (size_t)j * 64 * PITCH, (unsigned)__builtin_amdgcn_readfirstlane(vdst));
        if (F.tid < 64) bias[F.tid] = (Cref - CUM[(size_t)(64 * j + F.tid) * 8 + h]) * LOG2E;
        asm volatile("s_waitcnt vmcnt(0) lgkmcnt(0)" ::: "memory");
        __syncthreads();
        f32x16 c0, c1;
#pragma unroll
        for (int g = 0; g < 4; ++g) { const f32x4 b0 = *(LAS const f32x4*)(bias + 8 * g + 4 * hi), b1 = *(LAS const f32x4*)(bias + 32 + 8 * g + 4 * hi);
#pragma unroll
            for (int k = 0; k < 4; ++k) { c0[4 * g + k] = b0[k]; c1[4 * g + k] = b1[k]; } }
        f32x16 p0, p1;
        qkt2(p0, p1, F.lds + A_K, qr, c0, c1, r32, hi);
        const int jb = j - (NT - 4);
        if (jb >= 0) ab::cmask(p0, p1, jb, wid * 32 + r32, hi);
        softmax_pv(p0, p1, m, l, o, wsf, vb, r32, hi);
    }
    { auto rr = __builtin_amdgcn_permlane32_swap(__float_as_uint(l), __float_as_uint(l), false, false); l = __uint_as_float(rr[0]) + __uint_as_float(rr[1]); }
    asm volatile("" ::: "memory");
    if (hi == 0) wsf[32 + r32] = l;
    asm volatile("" ::: "memory");
    float rli[16];
#pragma unroll
    for (int r = 0; r < 16; ++r) rli[r] = __builtin_amdgcn_rcpf(wsf[32 + ab::crow(r, hi)]);
    LAS bf16* stg = (LAS bf16*)(F.lds + A_OST) + wid * 2048;
    stage_o(o, rli, stg, r32, hi);
    asm volatile("s_waitcnt lgkmcnt(0)" ::: "memory");
    bf16* Ow = (bf16*)(a.ws + WS_MIX) + (size_t)(t0 + wid * 32) * DM + h * 64;
#pragma unroll
    for (int i = 0; i < 4; ++i) { const int row = i * 8 + (lane >> 3), ch = lane & 7; const u32x4 v = *(LAS const u32x4*)(stg + row * 64 + ch * 8); *(u32x4*)(Ow + (size_t)row * DM + ch * 8) = v; }
}

__device__ __forceinline__ void moba_gate_chunk(const Args& a, Frame& F, int c) {
    const int own = c >> 2, h = F.wave, lane = F.lane, t = c * CHR + lane;
    if (own == 0) return;
    const bf16* P = (const bf16*)(a.ws + WS_PROJ); const float* KSUM = (const float*)(a.ws + WS_KSUM);
    LAS float* km = (LAS float*)(F.lds) + h * 4096;
    for (int n = 0; n < own; ++n) { const float* p = KSUM + (size_t)(4 * n) * 512 + h * 64 + lane; km[n * 64 + lane] = ((p[0] + p[512]) + (p[1024] + p[1536])) * (1.0f / 256.0f); }
    float q[64];
    { const bf16* qp = P + (size_t)t * PITCH + OFF_QB + h * 64;
#pragma unroll
      for (int i = 0; i < 8; ++i) { const u32x4 v = *(const u32x4*)(qp + 8 * i);
#pragma unroll
          for (int k = 0; k < 4; ++k) { q[8 * i + 2 * k] = __uint_as_float(v[k] << 16); q[8 * i + 2 * k + 1] = __uint_as_float(v[k] & 0xffff0000u); } } }
    float v1 = -INFINITY, v2 = -INFINITY, v3 = -INFINITY; int i1 = -1, i2 = -1, i3 = -1;
    for (int n = 0; n < own; ++n) {
        float g0 = 0.f, g1 = 0.f;
#pragma unroll
        for (int d = 0; d < 16; ++d) { const f32x4 kk = *(LAS const f32x4*)(km + n * 64 + 4 * d); g0 += q[4 * d] * kk[0] + q[4 * d + 1] * kk[1]; g1 += q[4 * d + 2] * kk[2] + q[4 * d + 3] * kk[3]; }
        const float g = g0 + g1;
        if (g > v1) { v3 = v2; i3 = i2; v2 = v1; i2 = i1; v1 = g; i1 = n; }
        else if (g > v2) { v3 = v2; i3 = i2; v2 = g; i2 = n; }
        else if (g > v3) { v3 = g; i3 = n; }
    }
    LAS int* cnt = (LAS int*)(F.lds + X_OFF) + h * 128; LAS int* gb = cnt + 64;
    cnt[lane] = 0;
    asm volatile("s_waitcnt lgkmcnt(0)" ::: "memory");
    int r1 = 0, r2 = 0, r3 = 0;
    if (i1 >= 0) r1 = (int)__hip_atomic_fetch_add(cnt + i1, 1, __ATOMIC_RELAXED, __HIP_MEMORY_SCOPE_WORKGROUP);
    if (i2 >= 0) r2 = (int)__hip_atomic_fetch_add(cnt + i2, 1, __ATOMIC_RELAXED, __HIP_MEMORY_SCOPE_WORKGROUP);
    if (i3 >= 0) r3 = (int)__hip_atomic_fetch_add(cnt + i3, 1, __ATOMIC_RELAXED, __HIP_MEMORY_SCOPE_WORKGROUP);
    asm volatile("s_waitcnt lgkmcnt(0)" ::: "memory");
    { const int cn = cnt[lane]; int b = 0; if (cn > 0) b = (int)__hip_atomic_fetch_add((unsigned*)(F.ctl + CW_GCNT + h * 64 + lane), (unsigned)cn, __ATOMIC_RELAXED, __HIP_MEMORY_SCOPE_AGENT); gb[lane] = b; }
    asm volatile("s_waitcnt vmcnt(0) lgkmcnt(0)" ::: "memory");
    int* ML = (int*)(a.ws + WS_MLIST) + (size_t)h * LCAP;
    if (i1 >= 0) ML[256 * (63 * i1 - (i1 * (i1 - 1)) / 2) + gb[i1] + r1] = t * 4 + 0;
    if (i2 >= 0) ML[256 * (63 * i2 - (i2 * (i2 - 1)) / 2) + gb[i2] + r2] = t * 4 + 1;
    if (i3 >= 0) ML[256 * (63 * i3 - (i3 * (i3 - 1)) / 2) + gb[i3] + r3] = t * 4 + 2;
}

__device__ __forceinline__ void moba_item(const Args& a, Frame& F, int h, int n, bool own, const int* list, int cnt) {
    const bf16* P = (const bf16*)(a.ws + WS_PROJ);
    const int lane = F.lane, r32 = lane & 31, hi = lane >> 5, wid = F.wave;
    __syncthreads();
    { const bf16* ksrc = P + OFF_KB + h * 64 + (size_t)(256 * n + lane) * PITCH + wid * 8;
      const bf16* vsrc = P + OFF_VB + h * 64 + (size_t)(256 * n + 16 * (wid & 3) + (lane >> 2)) * PITCH + (wid >> 2) * 32 + (lane & 3) * 8;
      const unsigned kdst = lds_addr(F.lds + A_K) + wid * 1024, vdst = lds_addr(F.lds + A_V) + wid * 1024;
#pragma unroll
      for (int jt = 0; jt < 4; ++jt) { ab::glds16(ksrc + (size_t)jt * 64 * PITCH, (unsigned)__builtin_amdgcn_readfirstlane(kdst + jt * 8192)); ab::glds16(vsrc + (size_t)jt * 64 * PITCH, (unsigned)__builtin_amdgcn_readfirstlane(vdst + jt * 8192)); } }
    int nv = cnt - wid * 32; nv = nv < 0 ? 0 : (nv > 32 ? 32 : nv);
    int ent;
    if (own) ent = ((256 * n + wid * 32 + r32) << 2) | 3;
    else { int idx = wid * 32 + r32; if (idx >= cnt) idx = cnt - 1; ent = list[idx]; }
    const int t = ent >> 2;
    bf16x8 qr[4];
    { const bf16* Qw = P + (size_t)t * PITCH + OFF_QB + h * 64;
#pragma unroll
      for (int d0 = 0; d0 < 4; ++d0) qr[d0] = *(const bf16x8*)(Qw + d0 * 16 + hi * 8); }
    asm volatile("s_waitcnt vmcnt(0) lgkmcnt(0)" ::: "memory");
    __syncthreads();
    if (nv > 0) {
        LAS const float* lut = (LAS const float*)(F.lds + A_LUT) + h * 512;
        LAS float* wsf = (LAS float*)(F.lds + A_WS) + wid * 64;
        const bool anynear = __any(t < 256 * (n + 2)) != 0;
        const float rb31 = lut[511];
        float m = -1e30f, l = 0.f; f32x16 o[2]; o[0] = f32x16{}; o[1] = f32x16{};
        const int vb0 = (int)lds_addr(F.lds + A_V) + ((lane >> 4) & 1) * 32 + (lane & 3) * 8 + (4 * hi + ((lane & 15) >> 2)) * 64;
        for (int jt = 0; jt < 4; ++jt) {
            if (own && 64 * jt > wid * 32 + 31) break;
            f32x16 cc;
            const float ci = anynear ? 0.f : rb31;
#pragma unroll
            for (int r = 0; r < 16; ++r) cc[r] = ci;
            f32x16 p0, p1;
            qkt2(p0, p1, F.lds + A_K + jt * 8192, qr, cc, cc, r32, hi);
            if (anynear) {
                const int kb = 256 * n + 64 * jt + 4 * hi;
#pragma unroll
                for (int r = 0; r < 16; ++r) { const int d0 = t - (kb + (r & 3) + 8 * (r >> 2)), d1 = d0 - 32;
                    const float b0 = lut[min(max(d0, 0), 511)], b1 = lut[min(max(d1, 0), 511)];
                    p0[r] = d0 < 0 ? -INFINITY : p0[r] + b0; p1[r] = d1 < 0 ? -INFINITY : p1[r] + b1; }
            }
            softmax_pv(p0, p1, m, l, o, wsf, vb0 + jt * 8192, r32, hi);
        }
        { auto rr = __builtin_amdgcn_permlane32_swap(__float_as_uint(l), __float_as_uint(l), false, false); l = __uint_as_float(rr[0]) + __uint_as_float(rr[1]); }
        float rli[16];
#pragma unroll
        for (int r = 0; r < 16; ++r) rli[r] = 1.0f;
        LAS bf16* stg = (LAS bf16*)(F.lds + A_OST) + wid * 2048;
        stage_o(o, rli, stg, r32, hi);
        asm volatile("s_waitcnt lgkmcnt(0)" ::: "memory");
        bf16* PO = (bf16*)(a.ws + WS_PO); float* PM = (float*)(a.ws + WS_PM); float* PL = (float*)(a.ws + WS_PL);
#pragma unroll
        for (int i = 0; i < 4; ++i) { const int row = i * 8 + (lane >> 3), ch = lane & 7; const int er = __shfl(ent, row);
            const u32x4 v = *(LAS const u32x4*)(stg + row * 64 + ch * 8);
            if (row < nv) *(u32x4*)(PO + ((size_t)((er >> 2) * 8 + h) * 4 + (er & 3)) * 64 + ch * 8) = v; }
        if (hi == 0 && r32 < nv) { const size_t pi = (size_t)(t * 8 + h) * 4 + (ent & 3); PM[pi] = m; PL[pi] = l; }
    }
}

__device__ __forceinline__ void build_lut(const Args& a, Frame& F) {
    LAS float* lut = (LAS float*)(F.lds + A_LUT);
    for (int i = F.tid; i < 8 * 512; i += NWAVES * 64) { const int h = i >> 9, d = i & 511; lut[i] = a.in[8][t5_bucket(d) * 8 + h] * LOG2E; }
    __syncthreads();
}
__device__ __forceinline__ void phase4(const Args& a, Frame& F) {
    for (int c = F.bid; c < NCHUNK; c += F.G) moba_gate_chunk(a, F, c);
    __syncthreads();
    build_lut(a, F);
    for (int u = F.bid; u < NH * 64; u += F.G) fox_unit(a, F, u & 7, u >> 3);
    for (int u = F.bid; u < NH * NMB; u += F.G) moba_item(a, F, u & 7, u >> 3, true, nullptr, 256);
}
__device__ __forceinline__ void phase5(const Args& a, Frame& F) {
    build_lut(a, F);
    LAS int* pfx = (LAS int*)(F.lds + A_PFX); LAS int* wt = (LAS int*)(F.lds + X_OFF);
    const int gc = (int)__hip_atomic_load(F.ctl + CW_GCNT + F.tid, RLX_AGENT);
    { int v = (gc + 255) >> 8;
#pragma unroll
      for (int o = 1; o < 64; o <<= 1) { const int y = __shfl_up(v, o); if (F.lane >= o) v += y; }
      if (F.lane == 63) wt[F.wave] = v;
      __syncthreads();
      int off = 0;
      for (int w = 0; w < F.wave; ++w) off += wt[w];
      pfx[F.tid + 1] = off + v; if (F.tid == 0) pfx[0] = 0;
      __syncthreads(); }
    const int nitems = pfx[512];
    for (int it = F.bid; it < nitems; it += F.G) {
        int lo = 0, hi = 512;
        while (hi - lo > 1) { const int mid = (lo + hi) >> 1; if (pfx[mid] <= it) lo = mid; else hi = mid; }
        const int pi = __builtin_amdgcn_readfirstlane(lo), g = it - __builtin_amdgcn_readfirstlane(pfx[lo]), h = pi >> 6, n = pi & 63;
        const int total = (int)__hip_atomic_load(F.ctl + CW_GCNT + pi, RLX_AGENT);
        int cnt = total - g * 256; cnt = cnt > 256 ? 256 : cnt;
        const int* list = (const int*)(a.ws + WS_MLIST) + (size_t)h * LCAP + 256 * (63 * n - (n * (n - 1)) / 2) + g * 256;
        moba_item(a, F, h, n, false, list, cnt);
    }
}
__device__ __forceinline__ void phase6(const Args& a, Frame& F) {
    const bf16* PO = (const bf16*)(a.ws + WS_PO); const float* PM = (const float*)(a.ws + WS_PM); const float* PL = (const float*)(a.ws + WS_PL);
    bf16* MIX = (bf16*)(a.ws + WS_MIX);
    const int gw = F.bid * NWAVES + F.wave, NGW = F.G * NWAVES, h = F.lane >> 3, dg = F.lane & 7;
    for (int t = gw; t < SEQ; t += NGW) {
        const int own = t >> 8, nsel = own < 3 ? own : 3; const size_t pb = (size_t)(t * 8 + h) * 4;
        float mi[4], li[4]; float M = -INFINITY;
#pragma unroll
        for (int i = 0; i < 4; ++i) { const bool valid = (i == 3) || (i < nsel); mi[i] = valid ? PM[pb + i] : -INFINITY; li[i] = valid ? PL[pb + i] : 0.f; M = fmaxf(M, mi[i]); }
        float L = 0.f; float acc[8];
#pragma unroll
        for (int k = 0; k < 8; ++k) acc[k] = 0.f;
#pragma unroll
        for (int i = 0; i < 4; ++i) { const bool valid = (i == 3) || (i < nsel);
            if (valid) { const float w = __builtin_amdgcn_exp2f(mi[i] - M); L += w * li[i]; const u32x4 v = *(const u32x4*)(PO + (pb + i) * 64 + dg * 8);
#pragma unroll
                for (int k = 0; k < 4; ++k) { acc[2 * k] += w * __uint_as_float(v[k] << 16); acc[2 * k + 1] += w * __uint_as_float(v[k] & 0xffff0000u); } } }
        const float inv = 1.0f / L;
        u32x4 o; o.x = ab::cvtpk_s(acc[0] * inv, acc[1] * inv); o.y = ab::cvtpk_s(acc[2] * inv, acc[3] * inv); o.z = ab::cvtpk_s(acc[4] * inv, acc[5] * inv); o.w = ab::cvtpk_s(acc[6] * inv, acc[7] * inv);
        *(u32x4*)(MIX + (size_t)t * DM + 512 + h * 64 + dg * 8) = o;
    }
}

__device__ __forceinline__ void phase8(const Args& a, Frame& F) {
    const float* mod = (const float*)(a.ws + WS_MOD);
    LAS float* wrT = (LAS float*)F.lds;
    for (int i = F.tid; i < 8192; i += NWAVES * 64) { const f32x4 v = ((const f32x4*)a.in[12])[i]; const int col = i >> 3, e0 = (i & 7) * 4;
        wrT[(e0 + 0) * 1024 + col] = v[0]; wrT[(e0 + 1) * 1024 + col] = v[1]; wrT[(e0 + 2) * 1024 + col] = v[2]; wrT[(e0 + 3) * 1024 + col] = v[3]; }
    LAS int* hist = (LAS int*)(F.lds + X_OFF); LAS int* ebase = hist + 32; LAS int* rsel = hist + 64; LAS int* rrank = rsel + 256; LAS float* rgate = (LAS float*)(rrank + 256);
    f32x4 GA[4], GB[4], GC[4];
#pragma unroll
    for (int j = 0; j < 4; ++j) { const int c = 256 * j + 4 * F.lane;
        GA[j] = *(const f32x4*)(a.in[5] + c) * *(const f32x4*)(mod + 2048 + c);
        GB[j] = *(const f32x4*)(a.in[10] + c) * (*(const f32x4*)(mod + 4096 + c) + 1.0f);
        GC[j] = *(const f32x4*)(mod + 3072 + c); }
    const float brt = a.in[13][F.lane >> 1];
    const bf16* AO = (const bf16*)(a.ws + WS_AO); bf16* XN = (bf16*)(a.ws + WS_XN);
    int* EIDX = (int*)(a.ws + WS_EIDX); float* GATE = (float*)(a.ws + WS_GATE); int* LOC = (int*)(a.ws + WS_LOC);
    const int hi = F.lane >> 5, b4 = (F.lane >> 4) & 1, b3 = (F.lane >> 3) & 1, b2 = (F.lane >> 2) & 1, b1 = (F.lane >> 1) & 1;
    for (int c = F.bid; c < NCHUNK; c += F.G) {
        if (F.tid < 32) hist[F.tid] = 0;
        __syncthreads();
        for (int rr = 0; rr < 8; ++rr) {
            const int rl = F.wave * 8 + rr, row = c * CHR + rl;
            f32x4 y[4]; float ss = 0.f;
#pragma unroll
            for (int j = 0; j < 4; ++j) { const u32x2 v = *(const u32x2*)(AO + (size_t)row * DM + 256 * j + 4 * F.lane);
                y[j] = (f32x4){__uint_as_float(v.x << 16), __uint_as_float(v.x & 0xffff0000u), __uint_as_float(v.y << 16), __uint_as_float(v.y & 0xffff0000u)};
                ss += (y[j][0] * y[j][0] + y[j][1] * y[j][1]) + (y[j][2] * y[j][2] + y[j][3] * y[j][3]); }
            const float rs1 = 1.0f / sqrtf(wave_sum(ss) * (1.0f / DM) + RMS_EPS);
            float ss2 = 0.f;
#pragma unroll
            for (int j = 0; j < 4; ++j) { const f32x4 xv = *(const f32x4*)(a.in[0] + (size_t)row * DM + 256 * j + 4 * F.lane);
                y[j] = xv + (y[j] * rs1) * GA[j];
                *(f32x4*)(a.out + (size_t)row * DM + 256 * j + 4 * F.lane) = y[j];
                ss2 += (y[j][0] * y[j][0] + y[j][1] * y[j][1]) + (y[j][2] * y[j][2] + y[j][3] * y[j][3]); }
            const float rs2 = 1.0f / sqrtf(wave_sum(ss2) * (1.0f / DM) + RMS_EPS);
#pragma unroll
            for (int j = 0; j < 4; ++j) { y[j] = (y[j] * rs2) * GB[j] + GC[j]; u32x2 o; o.x = ab::cvtpk_s(y[j][0], y[j][1]); o.y = ab::cvtpk_s(y[j][2], y[j][3]); *(u32x2*)(XN + (size_t)row * DM + 256 * j + 4 * F.lane) = o; }
            float p[32];
#pragma unroll
            for (int e = 0; e < 32; ++e) { float s = 0.f;
#pragma unroll
                for (int j = 0; j < 4; ++j) { const f32x4 w = *(const LAS f32x4*)(wrT + e * 1024 + 256 * j + 4 * F.lane); s += (y[j][0] * w[0] + y[j][1] * w[1]) + (y[j][2] * w[2] + y[j][3] * w[3]); }
                p[e] = s; }
            float q16[16], q8[8], q4[4], q2[2];
#pragma unroll
            for (int i = 0; i < 16; ++i) { const float send = hi ? p[i] : p[16 + i], keep = hi ? p[16 + i] : p[i]; q16[i] = keep + __shfl_xor(send, 32); }
#pragma unroll
            for (int i = 0; i < 8; ++i) { const float send = b4 ? q16[i] : q16[8 + i], keep = b4 ? q16[8 + i] : q16[i]; q8[i] = keep + __shfl_xor(send, 16); }
#pragma unroll
            for (int i = 0; i < 4; ++i) { const float send = b3 ? q8[i] : q8[4 + i], keep = b3 ? q8[4 + i] : q8[i]; q4[i] = keep + __shfl_xor(send, 8); }
#pragma unroll
            for (int i = 0; i < 2; ++i) { const float send = b2 ? q4[i] : q4[2 + i], keep = b2 ? q4[2 + i] : q4[i]; q2[i] = keep + __shfl_xor(send, 4); }
            float q1; { const float send = b1 ? q2[0] : q2[1], keep = b1 ? q2[1] : q2[0]; q1 = keep + __shfl_xor(send, 2); }
            float val = q1 + __shfl_xor(q1, 1) + brt;
            int sel[4]; float sv[4];
#pragma unroll
            for (int k = 0; k < 4; ++k) { const float mx = wave_max(val); const unsigned long long bm = __ballot(val == mx); const int ln = __ffsll((long long)bm) - 1;
                sel[k] = ln >> 1; sv[k] = mx; if ((F.lane >> 1) == sel[k]) val = -INFINITY; }
            const float e1 = __expf(sv[1] - sv[0]), e2 = __expf(sv[2] - sv[0]), e3 = __expf(sv[3] - sv[0]); const float inv = 1.0f / (1.0f + e1 + e2 + e3);
            if (F.lane == 0) {
#pragma unroll
                for (int k = 0; k < 4; ++k) { rsel[rl * 4 + k] = sel[k]; rrank[rl * 4 + k] = (int)__hip_atomic_fetch_add(hist + sel[k], 1, __ATOMIC_RELAXED, __HIP_MEMORY_SCOPE_WORKGROUP); }
                rgate[rl * 4 + 0] = inv; rgate[rl * 4 + 1] = e1 * inv; rgate[rl * 4 + 2] = e2 * inv; rgate[rl * 4 + 3] = e3 * inv; }
        }
        __syncthreads();
        if (F.tid < 32) { const int hc = hist[F.tid]; ebase[F.tid] = hc > 0 ? (int)__hip_atomic_fetch_add((unsigned*)(F.ctl + CW_ECNT + F.tid), (unsigned)hc, __ATOMIC_RELAXED, __HIP_MEMORY_SCOPE_AGENT) : 0; }
        __syncthreads();
        if (F.tid < 256) { const int e = rsel[F.tid]; const size_t gi = (size_t)(c * CHR) * 4 + F.tid; EIDX[gi] = e; LOC[gi] = ebase[e] + rrank[F.tid]; GATE[gi] = rgate[F.tid]; }
        __syncthreads();
    }
}

__device__ __forceinline__ int moe_layout(Frame& F, LAS int* pstart, LAS int* tileE) {
    if (F.tid == 0) { int acc = 0, T = 0;
        for (int e = 0; e < NE; ++e) { const int cn = (int)__hip_atomic_load(F.ctl + CW_ECNT + e, RLX_AGENT); const int nt = (cn + 255) >> 8; pstart[e] = acc; acc += nt * 256; for (int i = 0; i < nt; ++i) tileE[T++] = e; }
        pstart[NE] = acc; pstart[NE + 1] = T; }
    __syncthreads();
    return pstart[NE + 1];
}
__device__ __forceinline__ void phase9(const Args& a, Frame& F) {
    LAS int* pstart = (LAS int*)(F.lds + X_OFF); LAS int* tileE = pstart + 64;
    (void)moe_layout(F, pstart, tileE);
    const bf16* XN = (const bf16*)(a.ws + WS_XN); bf16* ROWS = (bf16*)(a.ws + WS_ROWS);
    const int* EIDX = (const int*)(a.ws + WS_EIDX); const float* GATE = (const float*)(a.ws + WS_GATE); const int* LOC = (const int*)(a.ws + WS_LOC);
    int* POS = (int*)(a.ws + WS_POS); float* ROWGATE = (float*)(a.ws + WS_ROWGATE);
    const int gw = F.bid * NWAVES + F.wave, NGW = F.G * NWAVES;
    for (int as = gw; as < SEQ * TOPK; as += NGW) {
        const int t = as >> 2, e = EIDX[as], dest = pstart[e] + LOC[as];
        const u32x4* src = (const u32x4*)(XN + (size_t)t * DM); u32x4* dst = (u32x4*)(ROWS + (size_t)dest * DM);
        const u32x4 v0 = src[F.lane], v1 = src[64 + F.lane]; dst[F.lane] = v0; dst[64 + F.lane] = v1;
        if (F.lane == 0) { POS[as] = dest; ROWGATE[dest] = GATE[as]; }
    }
    for (int e = 0; e < NE; ++e) { const int cn = (int)__hip_atomic_load(F.ctl + CW_ECNT + e, RLX_AGENT), pe = pstart[e + 1] - pstart[e];
        for (int r = cn + gw; r < pe; r += NGW) { u32x4* dst = (u32x4*)(ROWS + (size_t)(pstart[e] + r) * DM); dst[F.lane] = (u32x4){0u, 0u, 0u, 0u}; dst[64 + F.lane] = (u32x4){0u, 0u, 0u, 0u}; if (F.lane == 0) ROWGATE[pstart[e] + r] = 0.f; } }
}
__device__ __forceinline__ void phase12(const Args& a, Frame& F) {
    const float* mod = (const float*)(a.ws + WS_MOD);
    const bf16* Y = (const bf16*)(a.ws + WS_Y); const int* POS = (const int*)(a.ws + WS_POS);
    f32x4 GF[4];
#pragma unroll
    for (int j = 0; j < 4; ++j) { const int c = 256 * j + 4 * F.lane; GF[j] = *(const f32x4*)(a.in[11] + c) * *(const f32x4*)(mod + 5120 + c); }
    const int gw = F.bid * NWAVES + F.wave, NGW = F.G * NWAVES;
    for (int t = gw; t < SEQ; t += NGW) {
        f32x4 y[4];
#pragma unroll
        for (int j = 0; j < 4; ++j) y[j] = (f32x4){0.f, 0.f, 0.f, 0.f};
#pragma unroll
        for (int k = 0; k < 4; ++k) { const int pos = POS[t * 4 + k];
#pragma unroll
            for (int j = 0; j < 4; ++j) { const u32x2 v = *(const u32x2*)(Y + (size_t)pos * DM + 256 * j + 4 * F.lane);
                y[j] += (f32x4){__uint_as_float(v.x << 16), __uint_as_float(v.x & 0xffff0000u), __uint_as_float(v.y << 16), __uint_as_float(v.y & 0xffff0000u)}; } }
        float ss = 0.f;
#pragma unroll
        for (int j = 0; j < 4; ++j) ss += (y[j][0] * y[j][0] + y[j][1] * y[j][1]) + (y[j][2] * y[j][2] + y[j][3] * y[j][3]);
        const float rs = 1.0f / sqrtf(wave_sum(ss) * (1.0f / DM) + RMS_EPS);
        float* orow = a.out + (size_t)t * DM + 4 * F.lane;
#pragma unroll
        for (int j = 0; j < 4; ++j) { const f32x4 x1 = *(const f32x4*)(orow + 256 * j); *(f32x4*)(orow + 256 * j) = x1 + (y[j] * rs) * GF[j]; }
    }
}

constexpr int NPHASE = 13;
__global__ void __launch_bounds__(NWAVES * 64, 2) fwd_kernel(Args args) {
    extern __shared__ __attribute__((aligned(16))) unsigned char lds[];
    Frame F;
    F.lds = (LAS unsigned char*)lds;
    F.tid = threadIdx.x; F.lane = F.tid & 63; F.wave = __builtin_amdgcn_readfirstlane(F.tid >> 6);
    F.G = gridDim.x; F.bid = blockIdx.x;
    F.ctl = (gu32*)(args.ws + WS_CTL);
    volatile LAS unsigned* MISC = (volatile LAS unsigned*)(F.lds + MISC_OFF);
    if (F.tid < 64) MISC[F.tid] = 0u;
    __syncthreads();
    const int lo = args.ph_lo, hi = args.ph_hi;
    const bool multi = (hi - lo) > 1;
    XcdBarrier bar; bar.bar = (unsigned*)(F.ctl + CW_BAR); bar.x = 0; bar.st = nullptr;
    if (multi) bar = xcd_barrier_post((unsigned*)(F.ctl + CW_BAR), MISC + 8);
#define IN(k) (lo <= (k) && (k) < hi)
#define SEAM(k) do { if (IN(k) && IN((k) + 1)) xcd_barrier(bar); } while (0)
    const pg8::bf16_t* XNp = (const pg8::bf16_t*)(args.ws + WS_XN);

    if (IN(0)) { phase0(args, F); SEAM(0); }
    if (IN(1)) { phase1(args, F); SEAM(1); }
    if (IN(2)) {
        pg8::Gemm g{XNp, (const pg8::bf16_t*)(args.ws + WS_WTIN), SEQ, PITCH, DM}; pg8::StaticOrder S; S.init(SEQ, PITCH, F.G, F.bid);
        pg8::EpiProj E{(pg8::bf16_t*)(args.ws + WS_PROJ), PITCH, C2};
        pg8::gemm_phase<pg8::EpiProj, pg8::StaticOrder, PG8_ALIGN, PG8_SP2>(F.lds, g, S, E);
        SEAM(2);
    }
    if (IN(3)) { phase3(args, F); SEAM(3); }
    if (IN(4)) { phase4(args, F); SEAM(4); }
    if (IN(5)) { phase5(args, F); SEAM(5); }
    if (IN(6)) { phase6(args, F); SEAM(6); }
    if (IN(7)) {
        pg8::Gemm g{(const pg8::bf16_t*)(args.ws + WS_MIX), (const pg8::bf16_t*)(args.ws + WS_WTOUT), SEQ, DM, DM}; pg8::StaticOrder S; S.init(SEQ, DM, F.G, F.bid);
        pg8::EpiBf16<0> E{(pg8::bf16_t*)(args.ws + WS_AO), DM, nullptr, 0, 0, 1.f};
        pg8::gemm_phase<pg8::EpiBf16<0>, pg8::StaticOrder, PG8_ALIGN, PG8_SP2>(F.lds, g, S, E);
        SEAM(7);
    }
    if (IN(8)) { phase8(args, F); SEAM(8); }
    if (IN(9)) { phase9(args, F); SEAM(9); }
    if (IN(10)) {
        LAS int* pstart = (LAS int*)(F.lds + X_OFF); LAS int* tileE = pstart + 64;
        const int T = __builtin_amdgcn_readfirstlane(moe_layout(F, pstart, tileE));
        const int groups = (F.G % 8 == 0) ? 8 : 1, per = F.G / groups;
        pg8::MoeSched S{tileE, T, 8, groups == 8 ? (F.bid & 7) : 0, groups == 8 ? (F.bid >> 3) : F.bid, per, groups};
        pg8::Gemm g{(const pg8::bf16_t*)(args.ws + WS_ROWS), (const pg8::bf16_t*)(args.ws + WS_WTGU), RMAX, 2048, DM};
        pg8::EpiSwiglu E{(pg8::bf16_t*)(args.ws + WS_ACT), args.in[15]};
        pg8::gemm_phase<pg8::EpiSwiglu, pg8::MoeSched, PG8_ALIGN, PG8_SP2>(F.lds, g, S, E);
        SEAM(10);
    }
    if (IN(11)) {
        LAS int* pstart = (LAS int*)(F.lds + X_OFF); LAS int* tileE = pstart + 64;
        const int T = __builtin_amdgcn_readfirstlane(moe_layout(F, pstart, tileE));
        const int groups = (F.G % 8 == 0) ? 8 : 1, per = F.G / groups;
        pg8::MoeSched S{tileE, T, 4, groups == 8 ? (F.bid & 7) : 0, groups == 8 ? (F.bid >> 3) : F.bid, per, groups};
        pg8::Gemm g{(const pg8::bf16_t*)(args.ws + WS_ACT), (const pg8::bf16_t*)(args.ws + WS_WTDN), RMAX, 1024, DM};
        pg8::EpiDown E{(pg8::bf16_t*)(args.ws + WS_Y), args.in[17], (const float*)(args.ws + WS_ROWGATE)};
        pg8::gemm_phase<pg8::EpiDown, pg8::MoeSched, PG8_ALIGN, PG8_SP2>(F.lds, g, S, E);
        SEAM(11);
    }
    if (IN(12)) { phase12(args, F); }
#undef IN
#undef SEAM
}

#ifndef MK_PER_PHASE
#define MK_PER_PHASE 0
#endif
extern "C" void kernel_launch(void* const* d_in, const int* in_sizes, int n_in, void* d_out, int out_size, void* d_ws, size_t ws_size, hipStream_t stream) {
    static int grid = 0;
    if (grid == 0) {
        if (n_in != 18 || in_sizes[0] != SEQ * DM || out_size != SEQ * DM || ws_size < WS_END) { fprintf(stderr, "kernel_launch: unexpected shapes (n_in %d, in0 %d, out %d, ws %zu); nothing launched\n", n_in, n_in > 0 ? in_sizes[0] : -1, out_size, ws_size); grid = -1; return; }
        int dev = 0, cus = 0, per_cu = 0;
        if (hipGetDevice(&dev) != hipSuccess || hipDeviceGetAttribute(&cus, hipDeviceAttributeMultiprocessorCount, dev) != hipSuccess) { grid = -1; return; }
        if (hipFuncSetAttribute((const void*)fwd_kernel, hipFuncAttributeMaxDynamicSharedMemorySize, LDS_BYTES) != hipSuccess) { fprintf(stderr, "kernel_launch: hipFuncSetAttribute failed\n"); grid = -1; return; }
        if (hipOccupancyMaxActiveBlocksPerMultiprocessor(&per_cu, (const void*)fwd_kernel, NWAVES * 64, LDS_BYTES) != hipSuccess || per_cu < 1) { fprintf(stderr, "kernel_launch: occupancy query reports %d workgroups per CU\n", per_cu); }
        (void)hipGetLastError();
        grid = cus;
    }
    if (grid < 0) return;
    if (hipMemsetAsync((char*)d_ws + WS_CTL, 0, CTL_ZERO_BYTES, stream) != hipSuccess) return;
    Args a{};
    for (int i = 0; i < 18; ++i) a.in[i] = (const float*)d_in[i];
    a.out = (float*)d_out; a.ws = (unsigned char*)d_ws;
#if MK_PER_PHASE
    for (int p = 0; p < NPHASE; ++p) { a.ph_lo = p; a.ph_hi = p + 1; hipLaunchKernelGGL(fwd_kernel, dim3(grid), dim3(NWAVES * 64), LDS_BYTES, stream, a); }
#else
    a.ph_lo = 0; a.ph_hi = NPHASE; hipLaunchKernelGGL(fwd_kernel, dim3(grid), dim3(NWAVES * 64), LDS_BYTES, stream, a);
#endif
}
```

```cpp
#include <hip/hip_runtime.h>
#include <hip/hip_bf16.h>
#include <cstdio>
#include <cstdint>
#include <cmath>
namespace pg8 {
#define PG8_LAS __attribute__((address_space(3)))
typedef unsigned short bf16_t;
typedef short bf16x8 __attribute__((ext_vector_type(8)));
typedef float f32x4 __attribute__((ext_vector_type(4)));
typedef unsigned u32x4 __attribute__((ext_vector_type(4)));
constexpr int BM = 256, BK = 64, HALF = 128, HTB = HALF * BK * 2  , STAGE_BYTES = 8 * HTB, NXCD = 8, WGM = 8;

__host__ __device__ __forceinline__ int lds_byte(int r, int c) { const int st = (r >> 4) * 2 + (c >> 5), rr = r & 15, cc = c & 31, ob = rr * 64 + cc * 2; return st * 1024 + (ob ^ (((ob >> 9) & 1) << 5)); }
__host__ __device__ __forceinline__ void stage_rc(int b, int& R, int& C) { const int st = b / 1024, sb = b % 1024, swz = sb ^ (((sb >> 9) & 1) << 5); R = (st >> 1) * 16 + swz / 64; C = (st & 1) * 32 + (swz % 64) / 2; }
__host__ __device__ __forceinline__ int perm32(int rho) { const int n = rho >> 4, i = rho & 15; return 8 * (i >> 2) + 4 * n + (i & 3); }

struct Unit { int pm, pn, pb, e, nh; };
struct Gemm { const bf16_t* A; const bf16_t* Bt; int M, N, K; };

struct StaticOrder {
    int nM, nN, nwg, G, c;
    __host__ __device__ void init(int M, int N, int G_, int c_) { nM = M / BM; nN = N / BM; nwg = nM * nN; G = G_; c = c_; }
    __host__ __device__ bool next(int i, Unit& u) const {
        const long L = (long)i * G + c; if (L >= nwg) return false;
        int wgid = (int)L; { const int q = nwg / NXCD, r = nwg % NXCD, xcd = wgid % NXCD, off = wgid / NXCD; wgid = (xcd < r ? xcd * (q + 1) : r * (q + 1) + (xcd - r) * q) + off; }
        const int nig = WGM * nN, gid = wgid / nig, fm = gid * WGM, gsz = (nM - fm) < WGM ? (nM - fm) : WGM;
        u.pm = fm + ((wgid % nig) % gsz); u.pn = (wgid % nig) / gsz; u.pb = u.pn; u.e = 0; u.nh = 0; return true;
    }
    __device__ __forceinline__ void a_ready(const Unit&) const {}
    __device__ __forceinline__ void done(const Unit&) const {}
};

__device__ __forceinline__ unsigned cvt_pk_bf16(float lo, float hi) { unsigned r; asm volatile("v_cvt_pk_bf16_f32 %0, %1, %2" : "=v"(r) : "v"(lo), "v"(hi)); return r; }
typedef float f32x2 __attribute__((ext_vector_type(2)));
__device__ __forceinline__ f32x2 gelu_pk(f32x2 v) {
    const f32x2 av = __builtin_elementwise_abs(v), d = av * 0.2316418882f + 1.0f;
    f32x2 t; t.x = __builtin_amdgcn_rcpf(d.x); t.y = __builtin_amdgcn_rcpf(d.y);
    f32x2 q = t * 0.5307027145f + (-0.7265760135f); q = q * t + 0.7107068705f; q = q * t + (-0.142248368f); q = q * t + 0.127414796f; q = q * t;
    const f32x2 s = (v * v) * (-0.72134752044f);
    f32x2 e; e.x = __builtin_amdgcn_exp2f(s.x); e.y = __builtin_amdgcn_exp2f(s.y);
    const f32x2 m = v * (q * e), r = v - m;
    f32x2 o; o.x = v.x < 0.f ? m.x : r.x; o.y = v.y < 0.f ? m.y : r.y; return o;
}

template <int ACT  > struct EpiBf16 {
    static constexpr bool PERM = true, AFTER_DRAIN = false; static_assert(ACT == 0 || ACT == 1, "EpiBf16: ACT is 0 (none) or 1 (gelu_pk)");
    bf16_t* O; int ldc; const float* bias; int split_cols; size_t split_stride; float scale0;
    __device__ __forceinline__ void operator()(const f32x4 (&acc)[2][2][4][2], const Unit& u, int wr, int wc, int fr, int fq) const {
        const int row0 = u.pm * BM + wr * 64 + fr; int colt = u.pn * BM; bf16_t* base = O;
        float sc = 1.f; if (split_cols) { const int t = colt / split_cols; base += (size_t)t * split_stride; colt -= t * split_cols; if (t == 0) sc = scale0; }
        const int col0 = colt + wc * 32 + 8 * fq, bcol0 = u.pn * BM + wc * 32 + 8 * fq;
        f32x4 bv[2][2];
#pragma unroll
        for (int bj = 0; bj < 2; ++bj)
#pragma unroll
            for (int n = 0; n < 2; ++n) bv[bj][n] = bias ? *(const f32x4*)(bias + bcol0 + bj * HALF + 4 * n) : (f32x4){0.f, 0.f, 0.f, 0.f};
#pragma unroll
        for (int ai = 0; ai < 2; ++ai)
#pragma unroll
            for (int m = 0; m < 4; ++m) { bf16_t* rowp = base + (size_t)(row0 + ai * HALF + m * 16) * ldc + col0;
#pragma unroll
                for (int bj = 0; bj < 2; ++bj) { f32x4 v0 = acc[ai][bj][m][0] + bv[bj][0], v1 = acc[ai][bj][m][1] + bv[bj][1];
                    if (ACT == 1) { f32x2 a = gelu_pk((f32x2){v0[0], v0[1]}), b = gelu_pk((f32x2){v0[2], v0[3]}), c = gelu_pk((f32x2){v1[0], v1[1]}), d = gelu_pk((f32x2){v1[2], v1[3]});
                        v0 = (f32x4){a.x, a.y, b.x, b.y}; v1 = (f32x4){c.x, c.y, d.x, d.y}; }
                    v0 = v0 * sc; v1 = v1 * sc; u32x4 w; w.x = cvt_pk_bf16(v0[0], v0[1]); w.y = cvt_pk_bf16(v0[2], v0[3]); w.z = cvt_pk_bf16(v1[0], v1[1]); w.w = cvt_pk_bf16(v1[2], v1[3]);
                    *(u32x4*)(rowp + bj * HALF) = w; } }
    }
};
struct NoSide { static constexpr bool ACTIVE = false; };
template <class Epi, class Sched, bool ALIGN_EPI = false, bool SP2 = false, class Side = NoSide>
__device__ __forceinline__ void gemm_phase(PG8_LAS unsigned char* lds, const Gemm g, const Sched& S, const Epi& E, Side sd = Side()) {
    const int tid = threadIdx.x, wid = __builtin_amdgcn_readfirstlane(tid >> 6), lane = tid & 63, wr = wid >> 2, wc = wid & 3, fr = lane & 15, fq = lane >> 4;
    const int K = g.K, nt = K / BK;
    unsigned voffA[2], voffB[2];
#pragma unroll
    for (int i = 0; i < 2; ++i) { int R, C; stage_rc(tid * 16 + i * 8192, R, C); const int Rb = Epi::PERM ? ((R & ~31) + perm32(R & 31)) : R;
        voffA[i] = (unsigned)(R * K + C) * 2u; voffB[i] = (unsigned)(Rb * K + C) * 2u; }
    const size_t kstep = (size_t)(BK * 2);
    const size_t hstep = (size_t)HALF * K * 2;
    const size_t tstep = 2 * hstep;
    const unsigned ldsw = (unsigned)wid * 1024u;
    const int aoff = lds_byte(wr * 64 + fr, fq * 8), boff = lds_byte(wc * 32 + fr, fq * 8);
#define PG8_SA(b, h) (((b) * 2 + (h)) * HTB)
#define PG8_SB(b, h) ((4 + (b) * 2 + (h)) * HTB)
#define PG8_STAGE(bufoff, gbase, voff) do { _Pragma("unroll") for (int _i = 0; _i < 2; ++_i) \
        __builtin_amdgcn_global_load_lds((const unsigned*)((const char*)(gbase) + (voff)[_i]), (PG8_LAS unsigned*)(lds + (bufoff) + ldsw + _i * 8192), 16, 0, 0); } while (0)
#define PG8_LDA(dst, b, h) do { _Pragma("unroll") for (int m = 0; m < 4; ++m) _Pragma("unroll") for (int k = 0; k < 2; ++k) dst[m][k] = *(const PG8_LAS bf16x8*)(lds + PG8_SA(b, h) + aoff + m * 2048 + k * 1024); } while (0)
#define PG8_LDB(dst, b, h) do { _Pragma("unroll") for (int n = 0; n < 2; ++n) _Pragma("unroll") for (int k = 0; k < 2; ++k) dst[n][k] = *(const PG8_LAS bf16x8*)(lds + PG8_SB(b, h) + boff + n * 2048 + k * 1024); } while (0)
#define PG8_MMA(ai, bj, At, Bt) do { __builtin_amdgcn_s_setprio(1); _Pragma("unroll") for (int m = 0; m < 4; ++m) _Pragma("unroll") for (int n = 0; n < 2; ++n) _Pragma("unroll") for (int k = 0; k < 2; ++k) \
        acc[ai][bj][m][n] = __builtin_amdgcn_mfma_f32_16x16x32_bf16(Bt[n][k], At[m][k], acc[ai][bj][m][n], 0, 0, 0); __builtin_amdgcn_s_setprio(0); } while (0)
#define PG8_WAIT_V(n) asm volatile("s_waitcnt vmcnt(" #n ")" ::: "memory")
#define PG8_WAIT_L(n) asm volatile("s_waitcnt lgkmcnt(" #n ")" ::: "memory")
#define PG8_BAR __builtin_amdgcn_s_barrier()
#define PG8_SCHED __builtin_amdgcn_sched_barrier(0)
    Unit cur, nxt; int ui = 0;
    if (!S.next(0, cur)) return;
    f32x4 acc[2][2][4][2];
#pragma unroll
    for (int a = 0; a < 2; ++a)
#pragma unroll
        for (int b = 0; b < 2; ++b)
#pragma unroll
            for (int m = 0; m < 4; ++m)
#pragma unroll
                for (int n = 0; n < 2; ++n) acc[a][b][m][n] = (f32x4){0.f, 0.f, 0.f, 0.f};
    bf16x8 At[4][2], B0[2][2], B1[2][2];
    const char* cA = (const char*)g.A + (size_t)cur.pm * tstep; const char* cB = (const char*)g.Bt + (size_t)cur.pb * tstep;
    S.a_ready(cur);
    bool sfull = false, infl = false; float sv[16];
    if constexpr (Side::ACTIVE) { static_assert(SP2, "side stream: SP2 loop only"); if (sd.left > 0) { sd.issue(lds); sfull = true; } }
    if constexpr (SP2) {
        PG8_STAGE(PG8_SB(0, 0), cB, voffB); PG8_STAGE(PG8_SB(0, 1), cB + hstep, voffB); PG8_STAGE(PG8_SA(0, 0), cA, voffA); PG8_STAGE(PG8_SA(0, 1), cA + hstep, voffA);
        if (wr == 1) PG8_BAR;
        PG8_WAIT_V(2); PG8_BAR;
        PG8_STAGE(PG8_SB(1, 0), cB + kstep, voffB); PG8_STAGE(PG8_SA(1, 0), cA + kstep, voffA); PG8_STAGE(PG8_SB(1, 1), cB + hstep + kstep, voffB);
        PG8_WAIT_V(6); PG8_BAR;
    } else {
        PG8_STAGE(PG8_SB(0, 0), cB, voffB); PG8_STAGE(PG8_SA(0, 0), cA, voffA); PG8_STAGE(PG8_SB(0, 1), cB + hstep, voffB); PG8_STAGE(PG8_SA(0, 1), cA + hstep, voffA);
        if (wr == 1) PG8_BAR;
        PG8_WAIT_V(4); PG8_BAR;
        PG8_STAGE(PG8_SB(1, 0), cB + kstep, voffB); PG8_STAGE(PG8_SA(1, 0), cA + kstep, voffA); PG8_STAGE(PG8_SB(1, 1), cB + hstep + kstep, voffB);
        PG8_WAIT_V(6); PG8_BAR;
    }
    for (;;) {
        const bool has_next = S.next(ui + 1, nxt);
        const char* nA = has_next ? (const char*)g.A + (size_t)nxt.pm * tstep : cA; const char* nB = has_next ? (const char*)g.Bt + (size_t)nxt.pb * tstep : cB;
        for (int t = 0; t < nt; t += 2) {
            const bool last = (t == nt - 2);
            const char* a1 = cA + (size_t)(t + 1) * kstep;
            const char* a2 = last ? nA : cA + (size_t)(t + 2) * kstep; const char* b2 = last ? nB : cB + (size_t)(t + 2) * kstep;
            const char* a3 = a2 + kstep; const char* b3 = b2 + kstep;
            if (last && has_next) S.a_ready(nxt);
            if constexpr (SP2) {
            PG8_LDB(B0, 0, 0); PG8_LDB(B1, 0, 1); PG8_SCHED; PG8_LDA(At, 0, 0); PG8_STAGE(PG8_SA(1, 1), a1 + hstep, voffA);
            if (Side::ACTIVE && infl) PG8_WAIT_V(13); else PG8_WAIT_V(8);
            PG8_WAIT_L(0); PG8_BAR; PG8_MMA(0, 0, At, B0); PG8_MMA(0, 1, At, B1); PG8_BAR; PG8_SCHED;
            PG8_LDA(At, 0, 1); PG8_STAGE(PG8_SB(0, 0), b2, voffB); PG8_STAGE(PG8_SB(0, 1), b2 + hstep, voffB); PG8_STAGE(PG8_SA(0, 0), a2, voffA);
            if (Side::ACTIVE && infl) PG8_WAIT_V(13); else PG8_WAIT_V(8);
            PG8_WAIT_L(0); PG8_BAR; PG8_MMA(1, 0, At, B0); PG8_MMA(1, 1, At, B1); PG8_BAR; PG8_SCHED;
            PG8_LDB(B0, 1, 0); PG8_LDB(B1, 1, 1); PG8_SCHED; PG8_LDA(At, 1, 0); PG8_STAGE(PG8_SA(0, 1), a2 + hstep, voffA);
            PG8_WAIT_V(8); PG8_WAIT_L(0); PG8_BAR; PG8_MMA(0, 0, At, B0); PG8_MMA(0, 1, At, B1); PG8_BAR; PG8_SCHED;
            PG8_LDA(At, 1, 1);
            if constexpr (Side::ACTIVE) { if (sfull) sd.read(lds, sv, lane); }
            PG8_STAGE(PG8_SB(1, 0), b3, voffB); PG8_STAGE(PG8_SB(1, 1), b3 + hstep, voffB); PG8_STAGE(PG8_SA(1, 0), a3, voffA);
            PG8_WAIT_V(8); PG8_WAIT_L(0);
            const bool sst = sfull;
            if constexpr (Side::ACTIVE) { infl = false; if (sfull) { if (sd.left > 0) { sd.issue(lds); infl = true; } else sfull = false; } }
            PG8_BAR; PG8_MMA(1, 0, At, B0); PG8_MMA(1, 1, At, B1);
            if constexpr (Side::ACTIVE) { if (sst) sd.store(sv); }
            PG8_BAR; PG8_SCHED;
            } else {
            PG8_LDB(B0, 0, 0); PG8_SCHED; PG8_LDA(At, 0, 0); PG8_STAGE(PG8_SA(1, 1), a1 + hstep, voffA);
            PG8_WAIT_L(8); PG8_BAR; PG8_WAIT_L(0); PG8_MMA(0, 0, At, B0); PG8_BAR; PG8_SCHED;
            PG8_LDB(B1, 0, 1); PG8_STAGE(PG8_SB(0, 0), b2, voffB);
            PG8_BAR; PG8_WAIT_L(0); PG8_MMA(0, 1, At, B1); PG8_BAR;
            PG8_LDA(At, 0, 1); PG8_STAGE(PG8_SA(0, 0), a2, voffA);
            PG8_BAR; PG8_WAIT_L(0); PG8_MMA(1, 0, At, B0); PG8_BAR; PG8_SCHED;
            PG8_STAGE(PG8_SB(0, 1), b2 + hstep, voffB);
            PG8_WAIT_V(6); PG8_BAR; PG8_MMA(1, 1, At, B1); PG8_BAR;
            PG8_LDB(B0, 1, 0); PG8_SCHED; PG8_LDA(At, 1, 0); PG8_STAGE(PG8_SA(0, 1), a2 + hstep, voffA);
            PG8_WAIT_L(8); PG8_BAR; PG8_WAIT_L(0); PG8_MMA(0, 0, At, B0); PG8_BAR; PG8_SCHED;
            PG8_LDB(B1, 1, 1); PG8_STAGE(PG8_SB(1, 0), b3, voffB);
            PG8_BAR; PG8_WAIT_L(0); PG8_MMA(0, 1, At, B1); PG8_BAR;
            PG8_LDA(At, 1, 1); PG8_STAGE(PG8_SA(1, 0), a3, voffA);
            PG8_BAR; PG8_WAIT_L(0); PG8_MMA(1, 0, At, B0); PG8_BAR; PG8_SCHED;
            PG8_STAGE(PG8_SB(1, 1), b3 + hstep, voffB);
            PG8_WAIT_V(6); PG8_BAR; PG8_MMA(1, 1, At, B1); PG8_BAR;
            }
        }
        if constexpr (ALIGN_EPI) { if (wr == 0) PG8_BAR; }
        if constexpr (!Epi::AFTER_DRAIN) { E(acc, cur, wr, wc, fr, fq); S.done(cur); }
        if (!has_next) break;
#pragma unroll
        for (int a = 0; a < 2; ++a)
#pragma unroll
            for (int b = 0; b < 2; ++b)
#pragma unroll
                for (int m = 0; m < 4; ++m)
#pragma unroll
                    for (int n = 0; n < 2; ++n) acc[a][b][m][n] = (f32x4){0.f, 0.f, 0.f, 0.f};
        cur = nxt; cA = nA; cB = nB; ++ui;
        if constexpr (ALIGN_EPI) { if (wr == 1) PG8_BAR; }
    }
    PG8_WAIT_V(0);
    if constexpr (!ALIGN_EPI) { if (wr == 0) PG8_BAR; }
    PG8_BAR;
    if constexpr (Epi::AFTER_DRAIN) { E.fused(acc, cur, wr, wc, fr, fq, lds, wid, lane); S.done(cur); }
#undef PG8_SA
#undef PG8_SB
#undef PG8_STAGE
#undef PG8_LDA
#undef PG8_LDB
#undef PG8_MMA
#undef PG8_WAIT_V
#undef PG8_WAIT_L
#undef PG8_BAR
#undef PG8_SCHED
}
}
#ifndef PG8_SP2
#define PG8_SP2 true
#endif
#ifndef PG8_ALIGN
#define PG8_ALIGN true
#endif
namespace pg8 {
typedef int i32x4v __attribute__((ext_vector_type(4)));
typedef int i32x8v __attribute__((ext_vector_type(8)));
__device__ __forceinline__ const char* uptr(const char* p) { const unsigned long long v = (unsigned long long)p; const unsigned lo = __builtin_amdgcn_readfirstlane((unsigned)v), hi = __builtin_amdgcn_readfirstlane((unsigned)(v >> 32)); return (const char*)(((unsigned long long)hi << 32) | lo); }
struct Gemm2 { const unsigned char* A; const unsigned char* Bt; int K; const PG8_LAS int* xrow; };
template <class Epi, class Sched, bool ALIGN_EPI, bool FP8, bool GATHER>
__device__ __forceinline__ void gemm_phase2(PG8_LAS unsigned char* lds, const Gemm2 g, const Sched& S, const Epi& E) {
    const int tid = threadIdx.x, wid = __builtin_amdgcn_readfirstlane(tid >> 6), lane = tid & 63, wr = wid >> 2, wc = wid & 3, fr = lane & 15, fq = lane >> 4;
    constexpr int ESZ = FP8 ? 1 : 2, BKE = FP8 ? 128 : 64;
    const int K = g.K, nt = K / BKE;
    unsigned voffA[2], voffB[2], voffC[2][2], voffN[2][2];
#pragma unroll
    for (int i = 0; i < 2; ++i) { int R, C; stage_rc(tid * 16 + i * 8192, R, C); const int Rb = Epi::PERM ? ((R & ~31) + perm32(R & 31)) : R;
        voffA[i] = (unsigned)(R * K * ESZ + C * 2); voffB[i] = (unsigned)(Rb * K * ESZ + C * 2); }
    const size_t kstep = 128;
    const size_t hstep = (size_t)HALF * K * ESZ;
    const size_t tstep = 2 * hstep;
    const unsigned ldsw = (unsigned)wid * 1024u;
    const int aoff = lds_byte(wr * 64 + fr, fq * 8), boff = lds_byte(wc * 32 + fr, fq * 8);
#define PG8_SA(b, h) (((b) * 2 + (h)) * HTB)
#define PG8_SB(b, h) ((4 + (b) * 2 + (h)) * HTB)
#define PG8_STAGE(bufoff, gbase, voff) do { unsigned long long gb_ = (unsigned long long)(gbase); asm volatile("" : "+s"(gb_));   \
        _Pragma("unroll") for (int _i = 0; _i < 2; ++_i) \
        __builtin_amdgcn_global_load_lds((const unsigned*)((const char*)gb_ + (voff)[_i]), (PG8_LAS unsigned*)(lds + (bufoff) + ldsw + _i * 8192), 16, 0, 0); } while (0)
#define PG8_STA(bufoff, h, kofs, nx) do { if constexpr (GATHER) { unsigned long long ga_ = (unsigned long long)((const char*)g.A + (kofs)); asm volatile("" : "+s"(ga_)); _Pragma("unroll") for (int _i = 0; _i < 2; ++_i) \
        __builtin_amdgcn_global_load_lds((const unsigned*)((const char*)ga_ + ((nx) ? voffN[h][_i] : voffC[h][_i])), (PG8_LAS unsigned*)(lds + (bufoff) + ldsw + _i * 8192), 16, 0, 0); } \
        else { PG8_STAGE(bufoff, ((nx) ? nA : cA) + (h) * hstep + (kofs), voffA); } } while (0)
#define PG8_LDA(dst, b, h) do { _Pragma("unroll") for (int m = 0; m < 4; ++m) { dst[m].lo = *(const PG8_LAS i32x4v*)(lds + PG8_SA(b, h) + aoff + m * 2048); dst[m].hi = *(const PG8_LAS i32x4v*)(lds + PG8_SA(b, h) + aoff + m * 2048 + 1024); } } while (0)
#define PG8_LDB(dst, b, h) do { _Pragma("unroll") for (int n = 0; n < 2; ++n) { dst[n].lo = *(const PG8_LAS i32x4v*)(lds + PG8_SB(b, h) + boff + n * 2048); dst[n].hi = *(const PG8_LAS i32x4v*)(lds + PG8_SB(b, h) + boff + n * 2048 + 1024); } } while (0)
#define PG8_MMA(ai, bj, At, Bt) do { __builtin_amdgcn_s_setprio(1); _Pragma("unroll") for (int m = 0; m < 4; ++m) _Pragma("unroll") for (int n = 0; n < 2; ++n) { \
        if constexpr (FP8) { asm volatile("v_mfma_f32_16x16x128_f8f6f4 %0, %1, %2, %0" : "+v"(acc[ai][bj][m][n]) : "v"(Bt[n]), "v"(At[m]));   } \
        else { acc[ai][bj][m][n] = __builtin_amdgcn_mfma_f32_16x16x32_bf16(__builtin_bit_cast(bf16x8, Bt[n].lo), __builtin_bit_cast(bf16x8, At[m].lo), acc[ai][bj][m][n], 0, 0, 0); \
               acc[ai][bj][m][n] = __builtin_amdgcn_mfma_f32_16x16x32_bf16(__builtin_bit_cast(bf16x8, Bt[n].hi), __builtin_bit_cast(bf16x8, At[m].hi), acc[ai][bj][m][n], 0, 0, 0); } } \
        __builtin_amdgcn_s_setprio(0); } while (0)
#define PG8_WAIT_V(n) asm volatile("s_waitcnt vmcnt(" #n ")" ::: "memory")
#define PG8_WAIT_L(n) asm volatile("s_waitcnt lgkmcnt(" #n ")" ::: "memory")
#define PG8_BAR __builtin_amdgcn_s_barrier()
#define PG8_SCHED __builtin_amdgcn_sched_barrier(0)
#define PG8_GOFF(dst, q) do { int tl_ = (int)threadIdx.x; asm volatile("" : "+v"(tl_));   \
        _Pragma("unroll") for (int i_ = 0; i_ < 2; ++i_) { int R_, C_; stage_rc(tl_ * 16 + i_ * 8192, R_, C_); \
        _Pragma("unroll") for (int h_ = 0; h_ < 2; ++h_) dst[h_][i_] = (unsigned)(g.xrow[(q) * 256 + h_ * HALF + R_] * K * ESZ + C_ * 2); } } while (0)
    Unit cur, nxt; int ui = 0;
    if (!S.next(0, cur)) return;
    f32x4 acc[2][2][4][2];
#pragma unroll
    for (int a = 0; a < 2; ++a)
#pragma unroll
        for (int b = 0; b < 2; ++b)
#pragma unroll
            for (int m = 0; m < 4; ++m)
#pragma unroll
                for (int n = 0; n < 2; ++n) acc[a][b][m][n] = (f32x4){0.f, 0.f, 0.f, 0.f};
    i32x8v At[4], B0[2], B1[2];
    const char* cA = uptr(GATHER ? (const char*)g.A : (const char*)g.A + (size_t)cur.pm * tstep + (Sched::HALFM && cur.nh == 2 ? hstep : 0)); const char* cB = uptr((const char*)g.Bt + (size_t)cur.pb * tstep);
    const char* nA = cA;
    if constexpr (GATHER) { PG8_GOFF(voffC, 0);
#pragma unroll
        for (int h_ = 0; h_ < 2; ++h_)
#pragma unroll
            for (int i_ = 0; i_ < 2; ++i_) voffN[h_][i_] = voffC[h_][i_]; }
    S.a_ready(cur);
    PG8_STAGE(PG8_SB(0, 0), cB, voffB); PG8_STAGE(PG8_SB(0, 1), cB + hstep, voffB); PG8_STA(PG8_SA(0, 0), 0, 0, false); PG8_STA(PG8_SA(0, 1), 1, 0, false);
    if (wr == 1) PG8_BAR;
    PG8_WAIT_V(2); PG8_BAR;
    PG8_STAGE(PG8_SB(1, 0), cB + kstep, voffB); PG8_STA(PG8_SA(1, 0), 0, kstep, false); PG8_STAGE(PG8_SB(1, 1), cB + hstep + kstep, voffB);
    PG8_WAIT_V(6); PG8_BAR;
    for (;;) {
        const bool has_next = S.next(ui + 1, nxt);
        nA = uptr((has_next && !GATHER) ? (const char*)g.A + (size_t)nxt.pm * tstep + (Sched::HALFM && nxt.nh == 2 ? hstep : 0) : cA); const char* nB = uptr(has_next ? (const char*)g.Bt + (size_t)nxt.pb * tstep : cB);
        if constexpr (GATHER) { if (has_next) { PG8_GOFF(voffN, ui + 1); } }
#pragma unroll 1
        for (int t = 0; t < nt; t += 2) {
            const bool last = (t == nt - 2);
            const size_t k1 = (size_t)(t + 1) * kstep, k2 = last ? 0 : (size_t)(t + 2) * kstep, k3 = k2 + kstep;
            const char* b2 = last ? nB : cB + (size_t)(t + 2) * kstep; const char* b3 = b2 + kstep;
            if (last && has_next) S.a_ready(nxt);
            PG8_LDB(B0, 0, 0); PG8_LDB(B1, 0, 1); PG8_SCHED; PG8_LDA(At, 0, 0); PG8_STA(PG8_SA(1, 1), 1, k1, false);
            PG8_WAIT_V(8); PG8_WAIT_L(0); PG8_BAR; PG8_MMA(0, 0, At, B0); PG8_MMA(0, 1, At, B1); PG8_BAR; PG8_SCHED;
            if (!(Sched::HALFM && cur.nh)) PG8_LDA(At, 0, 1);
            PG8_STAGE(PG8_SB(0, 0), b2, voffB); PG8_STAGE(PG8_SB(0, 1), b2 + hstep, voffB); PG8_STA(PG8_SA(0, 0), 0, k2, last);
            PG8_WAIT_V(8); PG8_WAIT_L(0); PG8_BAR; if (!(Sched::HALFM && cur.nh)) { PG8_MMA(1, 0, At, B0); PG8_MMA(1, 1, At, B1); } PG8_BAR; PG8_SCHED;
            PG8_LDB(B0, 1, 0); PG8_LDB(B1, 1, 1); PG8_SCHED; PG8_LDA(At, 1, 0); PG8_STA(PG8_SA(0, 1), 1, k2, last);
            PG8_WAIT_V(8); PG8_WAIT_L(0); PG8_BAR; PG8_MMA(0, 0, At, B0); PG8_MMA(0, 1, At, B1); PG8_BAR; PG8_SCHED;
            if (!(Sched::HALFM && cur.nh)) PG8_LDA(At, 1, 1);
            PG8_STAGE(PG8_SB(1, 0), b3, voffB); PG8_STAGE(PG8_SB(1, 1), b3 + hstep, voffB); PG8_STA(PG8_SA(1, 0), 0, k3, last);
            PG8_WAIT_V(8); PG8_WAIT_L(0); PG8_BAR; if (!(Sched::HALFM && cur.nh)) { PG8_MMA(1, 0, At, B0); PG8_MMA(1, 1, At, B1); } PG8_BAR; PG8_SCHED;
        }
        if constexpr (ALIGN_EPI) { if (wr == 0) PG8_BAR; }
        if constexpr (FP8) { asm volatile("s_nop 15\n\ts_nop 7" ::: "memory"); __builtin_amdgcn_sched_barrier(0); }
        E(acc, cur, wr, wc, fr, fq); S.done(cur);
        if (!has_next) break;
#pragma unroll
        for (int a = 0; a < 2; ++a)
#pragma unroll
            for (int b = 0; b < 2; ++b)
#pragma unroll
                for (int m = 0; m < 4; ++m)
#pragma unroll
                    for (int n = 0; n < 2; ++n) acc[a][b][m][n] = (f32x4){0.f, 0.f, 0.f, 0.f};
        cur = nxt; cA = nA; cB = nB; ++ui;
        if constexpr (GATHER) {
#pragma unroll
            for (int h_ = 0; h_ < 2; ++h_)
#pragma unroll
                for (int i_ = 0; i_ < 2; ++i_) voffC[h_][i_] = voffN[h_][i_]; }
        if constexpr (ALIGN_EPI) { if (wr == 1) PG8_BAR; }
    }
    PG8_WAIT_V(0);
    if constexpr (!ALIGN_EPI) { if (wr == 0) PG8_BAR; }
    PG8_BAR;
#undef PG8_SA
#undef PG8_SB
#undef PG8_STAGE
#undef PG8_STA
#undef PG8_LDA
#undef PG8_LDB
#undef PG8_MMA
#undef PG8_WAIT_V
#undef PG8_WAIT_L
#undef PG8_BAR
#undef PG8_SCHED
#undef PG8_GOFF
}
}
namespace pg8 {
#ifndef USE_FP8
#define USE_FP8 1
#endif
constexpr bool FP8M_EPI = USE_FP8 != 0; constexpr float SACT_EPI = FP8M_EPI ? 4.f : 1.f, SY_EPI = 32.f;
typedef unsigned u32x2v __attribute__((ext_vector_type(2)));
__device__ __forceinline__ unsigned f8pk4e(float a, float b, float c, float d) {
    a = fminf(fmaxf(a, -448.f), 448.f); b = fminf(fmaxf(b, -448.f), 448.f); c = fminf(fmaxf(c, -448.f), 448.f); d = fminf(fmaxf(d, -448.f), 448.f);
    unsigned w = 0u; w = (unsigned)__builtin_amdgcn_cvt_pk_fp8_f32(a, b, (int)w, false); w = (unsigned)__builtin_amdgcn_cvt_pk_fp8_f32(c, d, (int)w, true); return w;
}
struct EpiProj {
    static constexpr bool PERM = true, AFTER_DRAIN = false;
    bf16_t* O; int ldc; float qscale;
    float* kms;
    unsigned* kn2h;
    unsigned* qn2h;
    __device__ __forceinline__ void operator()(const f32x4 (&acc)[2][2][4][2], const Unit& u, int wr, int wc, int fr, int fq) const {
        const int row0 = u.pm * BM + wr * 64 + fr, col0 = u.pn * BM + wc * 32 + 8 * fq;
        const float sc = (u.pn < 2 || u.pn == 6 || u.pn == 7) ? qscale : 1.f;
#pragma unroll
        for (int ai = 0; ai < 2; ++ai)
#pragma unroll
            for (int m = 0; m < 4; ++m) { bf16_t* rowp = O + (size_t)(row0 + ai * HALF + m * 16) * ldc + col0;
#pragma unroll
                for (int bj = 0; bj < 2; ++bj) { const f32x4 v0 = acc[ai][bj][m][0] * sc, v1 = acc[ai][bj][m][1] * sc;
                    u32x4 w; w.x = cvt_pk_bf16(v0[0], v0[1]); w.y = cvt_pk_bf16(v0[2], v0[3]); w.z = cvt_pk_bf16(v1[0], v1[1]); w.w = cvt_pk_bf16(v1[2], v1[3]);
                    *(u32x4*)(rowp + bj * HALF) = w; } }
        asm volatile("" : "+v"(fr), "+v"(fq));
        if (u.pn < 4) {
#pragma unroll
            for (int bj = 0; bj < 2; ++bj) { float mx = 0.f;
#pragma unroll
                for (int ai = 0; ai < 2; ++ai)
#pragma unroll
                    for (int m = 0; m < 4; ++m) { const f32x4 v0 = acc[ai][bj][m][0], v1 = acc[ai][bj][m][1];
                        float q = (v0[0] * v0[0] + v0[1] * v0[1]) + (v0[2] * v0[2] + v0[3] * v0[3]) + (v1[0] * v1[0] + v1[1] * v1[1]) + (v1[2] * v1[2] + v1[3] * v1[3]);
                        q += __shfl_xor(q, 16); q += __shfl_xor(q, 32); mx = fmaxf(mx, q); __builtin_amdgcn_sched_barrier(0); }
                mx = fmaxf(mx, __shfl_xor(mx, 1)); mx = fmaxf(mx, __shfl_xor(mx, 2)); mx = fmaxf(mx, __shfl_xor(mx, 4)); mx = fmaxf(mx, __shfl_xor(mx, 8));
                if (fr == 0 && fq == 0) { const int head = (u.pn & 1) * 4 + 2 * bj + (wc >> 1);
                    unsigned* ap = (u.pn < 2) ? qn2h + (u.pm * 8 + head) * 2 + (wc & 1) : kn2h + head * 2 + (wc & 1);
                    asm volatile("global_atomic_umax %0, %1, off" :: "v"(ap), "v"(__float_as_uint(mx * sc * sc)) : "memory"); } }
        } else if (u.pn == 8 || u.pn == 9) {
#pragma unroll
            for (int bj = 0; bj < 2; ++bj)
#pragma unroll
                for (int n = 0; n < 2; ++n)
#pragma unroll
                    for (int i = 0; i < 4; ++i) { float cs = 0.f;
#pragma unroll
                        for (int ai = 0; ai < 2; ++ai)
#pragma unroll
                            for (int m = 0; m < 4; ++m) cs += acc[ai][bj][m][n][i];
                        cs += __shfl_xor(cs, 1); cs += __shfl_xor(cs, 2); cs += __shfl_xor(cs, 4); cs += __shfl_xor(cs, 8); __builtin_amdgcn_sched_barrier(0);
                        if (fr == 0) { const int head = (u.pn - 8) * 4 + 2 * bj + (wc >> 1), d = 32 * (wc & 1) + 8 * fq + 4 * n + i; float* ap = kms + ((size_t)head * 64 + u.pm) * 64 + d;
                            asm volatile("global_atomic_add_f32 %0, %1, off" :: "v"(ap), "v"(cs) : "memory"); } }
        }
    }
};
struct EpiSwiglu {
    static constexpr bool PERM = true, AFTER_DRAIN = false;
    unsigned char* O; const float* bias; float sc;
    __device__ __forceinline__ void operator()(const f32x4 (&acc)[2][2][4][2], const Unit& u, int wr, int wc, int fr, int fq) const {
        asm volatile("" : "+v"(fr), "+v"(fq));
        const int row0 = u.pm * BM + wr * 64 + fr, oc0 = u.pn * HALF + wc * 32 + 8 * fq;
        const float* bg = bias + (size_t)u.e * 2048 + oc0;
        const f32x4 g0 = *(const f32x4*)(bg), g1 = *(const f32x4*)(bg + 4), l0 = *(const f32x4*)(bg + 1024), l1 = *(const f32x4*)(bg + 1028);
#pragma unroll
        for (int ai = 0; ai < 2; ++ai)
#pragma unroll
            for (int m = 0; m < 4; ++m) { const size_t eo = (size_t)(row0 + ai * HALF + m * 16) * 1024 + oc0;
                const f32x4 a0 = acc[ai][0][m][0] * sc + g0, a1 = acc[ai][0][m][1] * sc + g1, b0 = acc[ai][1][m][0] * sc + l0, b1 = acc[ai][1][m][1] * sc + l1;
                float r[8];
#pragma unroll
                for (int i = 0; i < 8; ++i) { const float xg = fminf(i < 4 ? a0[i & 3] : a1[i & 3], 7.0f); const float xl = __builtin_amdgcn_fmed3f(i < 4 ? b0[i & 3] : b1[i & 3], -7.0f, 7.0f);
                    const float sg = __builtin_amdgcn_rcpf(1.0f + __builtin_amdgcn_exp2f(xg * (-1.702f * 1.4426950408889634f)));
                    r[i] = (xg * sg) * (FP8M_EPI ? __builtin_fmaf(xl, SACT_EPI, SACT_EPI) : xl + 1.0f); }
                if constexpr (FP8M_EPI) { u32x2v w; unsigned w0 = 0u, w1 = 0u;
                    w0 = (unsigned)__builtin_amdgcn_cvt_pk_fp8_f32(r[0], r[1], (int)w0, false); w0 = (unsigned)__builtin_amdgcn_cvt_pk_fp8_f32(r[2], r[3], (int)w0, true);
                    w1 = (unsigned)__builtin_amdgcn_cvt_pk_fp8_f32(r[4], r[5], (int)w1, false); w1 = (unsigned)__builtin_amdgcn_cvt_pk_fp8_f32(r[6], r[7], (int)w1, true);
                    w.x = w0; w.y = w1; *(u32x2v*)(O + eo) = w; }
                else { u32x4 w; w.x = cvt_pk_bf16(r[0], r[1]); w.y = cvt_pk_bf16(r[2], r[3]); w.z = cvt_pk_bf16(r[4], r[5]); w.w = cvt_pk_bf16(r[6], r[7]); *(u32x4*)(O + eo * 2) = w; } }
    }
};
struct EpiDown {
    static constexpr bool PERM = true, AFTER_DRAIN = false;
    unsigned char* O; const float* bias; float sc;
    __device__ __forceinline__ void operator()(const f32x4 (&acc)[2][2][4][2], const Unit& u, int wr, int wc, int fr, int fq) const {
        asm volatile("" : "+v"(fr), "+v"(fq));
        const int row0 = u.pm * BM + wr * 64 + fr, col0 = u.pn * BM + wc * 32 + 8 * fq;
        const float* bp = bias + (size_t)u.e * 1024 + col0;
        f32x4 bv[2][2];
#pragma unroll
        for (int bj = 0; bj < 2; ++bj)
#pragma unroll
            for (int n = 0; n < 2; ++n) bv[bj][n] = *(const f32x4*)(bp + bj * HALF + 4 * n) * (FP8M_EPI ? SY_EPI : 1.0f);
        const float scy = FP8M_EPI ? sc * SY_EPI : sc;
#pragma unroll
        for (int ai = 0; ai < 2; ++ai) { if (u.nh != 0 && ai == 1) break;
#pragma unroll
            for (int m = 0; m < 4; ++m) { const int row = row0 + (u.nh == 2 ? HALF : 0) + ai * HALF + m * 16; const size_t eo = (size_t)row * 1024 + col0;
#pragma unroll
                for (int bj = 0; bj < 2; ++bj) { const f32x4 v0 = acc[ai][bj][m][0] * scy + bv[bj][0], v1 = acc[ai][bj][m][1] * scy + bv[bj][1];
                    if constexpr (FP8M_EPI) { u32x2v w; w.x = f8pk4e(v0[0], v0[1], v0[2], v0[3]); w.y = f8pk4e(v1[0], v1[1], v1[2], v1[3]); *(u32x2v*)(O + eo + bj * HALF) = w; }
                    else { u32x4 w; w.x = cvt_pk_bf16(v0[0], v0[1]); w.y = cvt_pk_bf16(v0[2], v0[3]); w.z = cvt_pk_bf16(v1[0], v1[1]); w.w = cvt_pk_bf16(v1[2], v1[3]); *(u32x4*)(O + (eo + bj * HALF) * 2) = w; } } } }
    }
};
template <bool HM>
struct MoeSched {
    static constexpr bool HALFM = HM;
    const PG8_LAS int* tileE; int T, NC, x, r, per, groups, maxu;
    __device__ __forceinline__ bool next(int i, Unit& u) const {
        const int lo = x * T / groups, hi = (x + 1) * T / groups, U = (hi - lo) * NC; int ul = i * per + r, nh = 0;
        if constexpr (HM) { const int full = U / per, L = U - full * per;
            if (i == full && L > 0 && 2 * L <= per) { if (r >= 2 * L) return false; ul = full * per + (r >> 1); nh = 1 + (r & 1); } }
        if (ul >= U || i >= maxu) return false;
        const int tile = lo + ul / NC, pn = ul % NC, e = __builtin_amdgcn_readfirstlane(tileE[tile]);
        u.pm = tile; u.pn = pn; u.pb = e * NC + pn; u.e = e; u.nh = nh; return true;
    }
    __device__ __forceinline__ void a_ready(const Unit&) const {}
    __device__ __forceinline__ void done(const Unit&) const {}
};
struct SideCvt {
    static constexpr bool ACTIVE = true;
    const char* sbase; unsigned char* dbase; unsigned voffs, voffd, lrd; int slot, left, ji, js; float sw;
    __device__ __forceinline__ void issue(PG8_LAS unsigned char* lds) {
        unsigned long long b = (unsigned long long)(sbase + (size_t)(ji & 15) * (64 * 8192) + (size_t)(ji >> 4) * 512); asm volatile("" : "+s"(b));
#pragma unroll
        for (int p = 0; p < 4; ++p) __builtin_amdgcn_global_load_lds((const unsigned*)((const char*)b + (size_t)p * 8192 + voffs), (PG8_LAS unsigned*)(lds + slot + p * 1024), 16, 0, 2);
        ++ji; --left;
    }
    __device__ __forceinline__ void read(PG8_LAS unsigned char* lds, float (&v)[16], int) const {
#pragma unroll
        for (int j = 0; j < 16; ++j) v[j] = *(const PG8_LAS float*)(lds + slot + (j & 3) * 1024 + (j >> 2) * 256 + lrd);
    }
    __device__ __forceinline__ void store(const float (&v)[16]) {
        u32x4 o; o.x = f8pk4e(v[0] * sw, v[1] * sw, v[2] * sw, v[3] * sw); o.y = f8pk4e(v[4] * sw, v[5] * sw, v[6] * sw, v[7] * sw);
        o.z = f8pk4e(v[8] * sw, v[9] * sw, v[10] * sw, v[11] * sw); o.w = f8pk4e(v[12] * sw, v[13] * sw, v[14] * sw, v[15] * sw);
        *(u32x4*)(dbase + (size_t)(js >> 4) * (256 * 1024) + (size_t)(js & 15) * 64 + voffd) = o; ++js;
    }
};
}
namespace attn_body {
using bf16=__hip_bfloat16;
using bf16x8=__attribute__((ext_vector_type(8)))short;
using s16x4=__attribute__((ext_vector_type(4)))short;
using f32x16=__attribute__((ext_vector_type(16)))float;
using u32x4=__attribute__((ext_vector_type(4)))unsigned;
__device__ __forceinline__ int crow(int r,int hi){return (r&3)+8*(r>>2)+4*hi;}
#define SBAR() __builtin_amdgcn_sched_barrier(0)
__device__ __forceinline__ void cmask(f32x16&p0,f32x16&p1,int jb,int qrel,int hi){
  const float NEG=-INFINITY; int kb=64*jb+4*hi;
  #pragma unroll
  for(int r=0;r<16;++r){int kv=kb+(r&3)+8*(r>>2); if(kv>qrel)p0[r]=NEG; if(kv+32>qrel)p1[r]=NEG;}
}
__device__ __forceinline__ void glds16(const void*gsrc,unsigned lds_dst){unsigned keep;
  asm volatile("s_mov_b32 %0, m0\n\ts_mov_b32 m0, %2\n\ts_nop 0\n\tglobal_load_lds_dwordx4 %1, off\n\ts_mov_b32 m0, %0":"=&s"(keep):"v"(gsrc),"s"(lds_dst):"memory");}
__device__ __forceinline__ float max3f(float a,float b,float c){float r;asm("v_max3_f32 %0, %1, %2, %3":"=v"(r):"v"(a),"v"(b),"v"(c));return r;}
__device__ __forceinline__ float max2f(float a,float b){float r;asm("v_max_f32_e32 %0, %1, %2":"=v"(r):"v"(a),"v"(b));return r;}
__device__ __forceinline__ float fadd_s(float a,float b){float r;asm("v_add_f32_e32 %0, %1, %2":"=v"(r):"v"(a),"v"(b));return r;}
__device__ __forceinline__ float fsub_s(float a,float b){float r;asm("v_sub_f32_e32 %0, %1, %2":"=v"(r):"v"(a),"v"(b));return r;}
typedef float f32x2_t __attribute__((ext_vector_type(2))); typedef __bf16 bf16x2_t __attribute__((ext_vector_type(2)));
__device__ __forceinline__ unsigned cvtpk_s(float lo,float hi){f32x2_t v={lo,hi};bf16x2_t b=__builtin_convertvector(v,bf16x2_t);return __builtin_bit_cast(unsigned,b);}
__device__ __forceinline__ float rowmax(const f32x16&p0,const f32x16&p1){
  float a=max3f(p0[0],p0[1],p1[0]),b=max3f(p0[2],p0[3],p1[1]);a=max3f(a,p1[2],p1[3]);
  #pragma unroll
  for(int r=4;r<16;r+=4){a=max3f(a,p0[r],p0[r+1]);b=max3f(b,p0[r+2],p0[r+3]);a=max3f(a,p1[r],p1[r+1]);b=max3f(b,p1[r+2],p1[r+3]);}
  const float m=max2f(a,b);
  auto rr=__builtin_amdgcn_permlane32_swap(__float_as_uint(m),__float_as_uint(m),false,false);
  return max2f(__uint_as_float(rr[0]),__uint_as_float(rr[1]));
}
__device__ __forceinline__ void pv(f32x16*o,int vb,bf16x8 pa0,bf16x8 pa1,bf16x8 pa2,bf16x8 pa3){
  #pragma unroll
  for(int d0=0;d0<2;++d0){s16x4 lo[4],hi[4];
    #pragma unroll
    for(int ks=0;ks<4;++ks){
      asm volatile("ds_read_b64_tr_b16 %0,%1 offset:%c2":"=&v"(lo[ks]):"v"(vb),"i"(d0*4096+ks*1024):"memory");
      asm volatile("ds_read_b64_tr_b16 %0,%1 offset:%c2":"=&v"(hi[ks]):"v"(vb),"i"(d0*4096+ks*1024+512):"memory");}
    asm volatile("s_waitcnt lgkmcnt(0)":::"memory");SBAR();
    #define PK(k) (bf16x8){lo[k][0],lo[k][1],lo[k][2],lo[k][3],hi[k][0],hi[k][1],hi[k][2],hi[k][3]}
    o[d0]=__builtin_amdgcn_mfma_f32_32x32x16_bf16(pa0,PK(0),o[d0],0,0,0);
    o[d0]=__builtin_amdgcn_mfma_f32_32x32x16_bf16(pa1,PK(1),o[d0],0,0,0);
    o[d0]=__builtin_amdgcn_mfma_f32_32x32x16_bf16(pa2,PK(2),o[d0],0,0,0);
    o[d0]=__builtin_amdgcn_mfma_f32_32x32x16_bf16(pa3,PK(3),o[d0],0,0,0);
    #undef PK
  }
}
#undef SBAR
}
#define GAS __attribute__((address_space(1)))
#define LAS __attribute__((address_space(3)))
typedef unsigned short bf16;
typedef unsigned v4u __attribute__((ext_vector_type(4)));
typedef float f32x4 __attribute__((ext_vector_type(4)));
typedef short bf16x8 __attribute__((ext_vector_type(8)));
typedef GAS unsigned gu32;
typedef GAS unsigned long long gu64;
#define RLX_AGENT __ATOMIC_RELAXED, __HIP_MEMORY_SCOPE_AGENT
#define LDS_WAIT() asm volatile("s_waitcnt lgkmcnt(0)" ::: "memory")
#define VM_WAIT() asm volatile("s_waitcnt vmcnt(0)" ::: "memory")
__device__ __forceinline__ unsigned long long rt() { return __builtin_amdgcn_s_memrealtime(); }
__device__ __forceinline__ unsigned f2bf(float f) { unsigned u = __builtin_bit_cast(unsigned, f); return (u + 0x7fffu + ((u >> 16) & 1u)) >> 16; }
__device__ __forceinline__ unsigned pk2(float lo, float hi) { return f2bf(lo) | (f2bf(hi) << 16); }

#define XB_TMO      128
#define XB_XCNT(j)  (256  + 64 * (j))
#define XB_XSUB(j)  (1280 + 64 * (j))
#define XB_XGEN(j)  (2304 + 64 * (j))
#define XB_TOP      3328
#define XB_TOPGEN   3392
#define XCD_BAR_WORDS 3456
#define XB_SPIN_CAP (1u << 18)

__device__ __forceinline__ unsigned xb_ld(unsigned* p)              { return __hip_atomic_load(p, __ATOMIC_RELAXED, __HIP_MEMORY_SCOPE_AGENT); }
__device__ __forceinline__ unsigned xb_add(unsigned* p, unsigned v) { return __hip_atomic_fetch_add(p, v, __ATOMIC_RELAXED, __HIP_MEMORY_SCOPE_AGENT); }
__device__ __forceinline__ unsigned xb_xcc_id() { return (unsigned)__builtin_amdgcn_s_getreg((3 << 11) | 20) & 0xFu; }
#define XB_SPIN(cond, bar) do { unsigned _sp = 0; while (cond) { __builtin_amdgcn_s_sleep(1); \
    if ((++_sp & 255u) == 0u) { if (xb_ld(&(bar)[XB_TMO])) break; if (_sp > XB_SPIN_CAP) { atomicAdd(&(bar)[XB_TMO], 1u); break; } } } } while (0)

struct XcdBarrier {
    unsigned* bar; unsigned x;
    volatile LAS unsigned* st;
};

__device__ __forceinline__ XcdBarrier xcd_barrier_post(unsigned* bar, volatile LAS unsigned* st) {
    XcdBarrier b; b.bar = bar; b.x = xb_xcc_id(); b.st = st;
    if (threadIdx.x == 0) (void)xb_add(&bar[XB_XCNT(b.x)], 1u);
    return b;
}
__device__ __forceinline__ void xcd_barrier_complete(unsigned* bar, unsigned x, unsigned& nloc, unsigned& nx) {
    const unsigned G = gridDim.x * gridDim.y * gridDim.z;
    unsigned sum, cnt, mine, sp = 0u;
    for (;;) {
        sum = 0u; cnt = 0u; mine = 0u;
#pragma unroll
        for (unsigned j = 0; j < 16; ++j) { const unsigned c = xb_ld(&bar[XB_XCNT(j)]); sum += c; cnt += (c > 0u) ? 1u : 0u; mine = (j == x) ? c : mine; }
        if (sum == G) break;
        __builtin_amdgcn_s_sleep(1);
        if ((++sp & 255u) == 0u) { if (xb_ld(&bar[XB_TMO])) break; if (sp > XB_SPIN_CAP) { atomicAdd(&bar[XB_TMO], 1u); break; } }
    }
    nloc = mine > 0u ? mine : 1u; nx = cnt > 0u ? cnt : 1u;
}

__device__ __forceinline__ void xcd_barrier(const XcdBarrier& b) {
    asm volatile("s_waitcnt vmcnt(0)" ::: "memory");
    __syncthreads();
    if (threadIdx.x == 0) {
        unsigned* bar = b.bar;
        __builtin_amdgcn_s_waitcnt(0);
        unsigned nloc = b.st[0], nx = b.st[1];
        if (nloc == 0u) { xcd_barrier_complete(bar, b.x, nloc, nx); b.st[0] = nloc; b.st[1] = nx; }
        const unsigned old = xb_add(&bar[XB_XSUB(b.x)], 1u);
        const unsigned gen = old / nloc;
        if (old + 1u == (gen + 1u) * nloc) {
            __builtin_amdgcn_fence(__ATOMIC_RELEASE, "agent");
            asm volatile("s_waitcnt vmcnt(0)" ::: "memory");
            const unsigned og = xb_add(&bar[XB_TOP], 1u);
            const unsigned tg = og / nx;
            if (og + 1u == (tg + 1u) * nx) xb_add(&bar[XB_TOPGEN], 1u);
            else XB_SPIN(xb_ld(&bar[XB_TOPGEN]) == tg, bar);
            __builtin_amdgcn_fence(__ATOMIC_ACQUIRE, "agent");
            xb_add(&bar[XB_XGEN(b.x)], 1u);
            asm volatile("s_waitcnt vmcnt(0)" ::: "memory");
        } else {
            XB_SPIN(xb_ld(&bar[XB_XGEN(b.x)]) == gen, bar);
            __builtin_amdgcn_fence(__ATOMIC_ACQUIRE, "agent");
            asm volatile("s_waitcnt vmcnt(0)" ::: "memory");
        }
    }
    __syncthreads();
}
#ifndef USE_FP8
#define USE_FP8 1
#endif
constexpr bool FP8M = USE_FP8 != 0;
constexpr int MESZ = FP8M ? 1 : 2;
constexpr float S_Y = 32.f;
constexpr float S_W = FP8M ? 256.f : 1.f, S_A = FP8M ? 8.f : 1.f, S_ACT = FP8M ? 4.f : 1.f;
namespace ab = attn_body;
using ab::f32x16;
typedef unsigned u32x4 __attribute__((ext_vector_type(4)));
typedef unsigned u32x2 __attribute__((ext_vector_type(2)));

constexpr int NWAVES = 8;
constexpr int SEQ = 16384, DM = 1024, NH = 8, HD = 64, PITCH = 3072, INW = 3080;
constexpr int NE = 32, TOPK = 4;
constexpr int NCHUNK = 256, CHR = 64;
constexpr int NMB = 64;
constexpr int RMAX = 65536 + 32 * 256, TMAX = RMAX / 256;
constexpr float RMS_EPS = 1e-6f, LOG2E = 1.4426950408889634f, C2 = 0.125f * 1.4426950408889634f;
constexpr int LCAP = 256 * 2016;
constexpr int OFF_QA = 0, OFF_KA = 512, OFF_VA = 1024, OFF_QB = 1536, OFF_KB = 2048, OFF_VB = 2560;

constexpr size_t MiB = 1u << 20;
constexpr size_t WS_CTL = 0, CTL_ZERO_BYTES = 393216;
constexpr size_t WS_MOD = 1 * MiB, WS_TOT = WS_MOD + 65536, WS_RS1 = WS_MOD + 131072;
constexpr size_t WS_LOGF = 2 * MiB, WS_CUM = 2 * MiB + 524288;
constexpr size_t WS_WTOUT = 4 * MiB, WS_WTIN = 6 * MiB;
constexpr size_t WS_WRT = 3 * MiB + 524288;
constexpr size_t WS_WFT = 3 * MiB + 786432;
constexpr size_t WS_XNLO = 914 * MiB;
constexpr size_t WS_EIDX = 12 * MiB, WS_GATE = WS_EIDX + 262144, WS_LOC = WS_GATE + 262144;
constexpr size_t WS_ELIST = 946 * MiB;
constexpr size_t WS_XN8 = 948 * MiB;
constexpr size_t WS_PM = 14 * MiB, WS_PL = 16 * MiB, WS_MLIST = 18 * MiB;
constexpr size_t WS_XN = 34 * MiB, WS_PROJ = 66 * MiB, WS_MIX = 162 * MiB, WS_AO = 194 * MiB, WS_PO = 226 * MiB;
constexpr size_t WS_WTGU = 290 * MiB, WS_WTDN = 418 * MiB, WS_ACT = 626 * MiB, WS_Y = 770 * MiB, WS_END = 964 * MiB;
static_assert((size_t)NH * LCAP * 4 <= 16 * MiB && (size_t)RMAX * 1024 * 2 == 144 * MiB, "d_ws map");
constexpr int CW_BAR = 4096;
constexpr int CW_GCNT = 32768;
constexpr int CW_ECNT = 40960;
constexpr int CW_KN2H = 49152;
constexpr int CW_QN2H = 50176;
constexpr int CW_KMS = 65536;
static_assert((CW_KMS + 8 * 64 * 64) * 4 <= (int)CTL_ZERO_BYTES, "CTL words inside the memset");

constexpr int RING_BYTES = 131072;
constexpr int MISC_OFF = RING_BYTES;
constexpr int X_OFF = RING_BYTES + 256;
constexpr int LDS_BYTES = 163840;
constexpr int A_K = 0, A_V = 32768, A_LUT = 65536, A_WS = 81920, A_OST = 84224, A_PFX = 116992;

struct Args { const float* in[18]; float* out; unsigned char* ws; int ph_lo, ph_hi; };
struct Frame { LAS unsigned char* lds; gu32* ctl; int tid, lane, wave, G, bid; };

#ifndef SIDE_GU
#define SIDE_GU 1
#endif
__device__ __forceinline__ bool side_gu(int G) { return SIDE_GU && FP8M && G == 256; }
__device__ __forceinline__ pg8::SideCvt side_make(const Args& a, const Frame& F, int j0, int n);
__device__ __forceinline__ int vchunk(int c, int G) { return (G == 256) ? ((c & 7) * 32 + (c >> 3)) : c; }
__device__ __forceinline__ float bf2f(unsigned short b) { return __uint_as_float((unsigned)b << 16); }
__device__ __forceinline__ float wave_sum(float v) {
#pragma unroll
    for (int o = 1; o < 64; o <<= 1) v += __shfl_xor(v, o);
    return v;
}
__device__ __forceinline__ float wave_max(float v) {
#pragma unroll
    for (int o = 1; o < 64; o <<= 1) v = fmaxf(v, __shfl_xor(v, o));
    return v;
}
__device__ __forceinline__ double wave_sum_d(double v) {
#pragma unroll
    for (int o = 1; o < 64; o <<= 1) { const int lo = __shfl_xor(__double2loint(v), o), hi = __shfl_xor(__double2hiint(v), o); v += __hiloint2double(hi, lo); }
    return v;
}
__device__ __forceinline__ unsigned f8pk4(float a, float b, float c, float d) {
    a = fminf(fmaxf(a, -448.f), 448.f); b = fminf(fmaxf(b, -448.f), 448.f); c = fminf(fmaxf(c, -448.f), 448.f); d = fminf(fmaxf(d, -448.f), 448.f);
    unsigned w = 0u; w = (unsigned)__builtin_amdgcn_cvt_pk_fp8_f32(a, b, (int)w, false); w = (unsigned)__builtin_amdgcn_cvt_pk_fp8_f32(c, d, (int)w, true); return w;
}
__device__ __forceinline__ unsigned lds_addr(LAS const void* p) { return (unsigned)(uintptr_t)p; }
__device__ __forceinline__ int t5_bucket(int d) {
    if (d < 16) return d;
    int b = 16;
    b += (d >= 19); b += (d >= 21); b += (d >= 24); b += (d >= 27); b += (d >= 31); b += (d >= 35); b += (d >= 40); b += (d >= 46);
    b += (d >= 52); b += (d >= 59); b += (d >= 67); b += (d >= 77); b += (d >= 87); b += (d >= 99); b += (d >= 113);
    return b;
}

struct CvtItem { const float* src; unsigned char* dst; int ldn; int esz; };
constexpr int CVT_NITEMS = 96 + 32 + 2048 + 1024;
__device__ __forceinline__ CvtItem cvt_decode(const Args& a, int it, int w, int ngu) {
    CvtItem c;
    if (it < 96) { const int ng = (it >> 4) * 8 + w, kg = it & 15; c.src = a.in[6] + (size_t)(kg * 64) * INW + ng * 64; c.ldn = INW; c.dst = a.ws + WS_WTIN + ((size_t)(ng * 64) * 1024 + kg * 64) * 2; c.esz = 2; return c; }
    it -= 96;
    if (it < 32) { const int ng = (it >> 4) * 8 + w, kg = it & 15; c.src = a.in[9] + (size_t)(kg * 64) * 1024 + ng * 64; c.ldn = 1024; c.dst = a.ws + WS_WTOUT + ((size_t)(ng * 64) * 1024 + kg * 64) * 2; c.esz = 2; return c; }
    it -= 32;
    if (it < ngu) { const int e = it >> 6, rem = it & 63, ng = (rem >> 4) * 8 + w, kg = rem & 15, c0 = ng * 64;
        const int drow = (c0 < 1024) ? (c0 >> 7) * 256 + (c0 & 127) : ((c0 - 1024) >> 7) * 256 + 128 + ((c0 - 1024) & 127);
        c.src = a.in[14] + (size_t)e * 1024 * 2048 + (size_t)(kg * 64) * 2048 + c0; c.ldn = 2048; c.dst = a.ws + WS_WTGU + ((size_t)(e * 2048 + drow) * 1024 + kg * 64) * MESZ; c.esz = MESZ; return c; }
    it -= ngu;
    { const int e = it >> 5, rem = it & 31, ng = (rem >> 4) * 8 + w, kg = rem & 15;
      c.src = a.in[16] + (size_t)e * 1024 * 1024 + (size_t)(kg * 64) * 1024 + ng * 64; c.ldn = 1024; c.dst = a.ws + WS_WTDN + ((size_t)(e * 1024 + ng * 64) * 1024 + kg * 64) * MESZ; c.esz = MESZ; return c; }
}
__device__ __forceinline__ pg8::SideCvt side_make(const Args& a, const Frame& F, int j0, int n) {
    const int c = F.bid, e = c >> 3, c0 = ((2 * c) & 15) * 128 + F.wave * 16;
    const int drow = (c0 < 1024) ? (c0 >> 7) * 256 + (c0 & 127) : ((c0 - 1024) >> 7) * 256 + 128 + ((c0 - 1024) & 127);
    pg8::SideCvt sd;
    sd.sbase = pg8::uptr((const char*)(a.in[14] + (size_t)e * 1024 * 2048 + c0));
    sd.dbase = (unsigned char*)pg8::uptr((const char*)(a.ws + WS_WTGU + (size_t)(e * 2048 + drow) * 1024));
    const int l = F.lane;
    sd.voffs = (unsigned)((16 * ((l & 15) >> 2) + 4 * (l >> 4)) * 8192 + (l & 3) * 16); sd.voffd = (unsigned)((l >> 2) * 1024 + (l & 3) * 16); sd.lrd = (unsigned)((l & 3) * 64 + (l >> 2) * 4);
    sd.slot = RING_BYTES + F.wave * 4096; sd.left = n; sd.ji = j0; sd.js = j0; sd.sw = S_W;
    return sd;
}
__device__ __forceinline__ void phase0(const Args& a, Frame& F) {
    float* mod = (float*)(a.ws + WS_MOD);
    {
        LAS float* red = (LAS float*)F.lds;
        const float* cvec = a.in[1]; const float* W = a.in[2];
        if (F.bid == F.G - 1) {
            bf16* WH = (bf16*)(a.ws + WS_WRT); bf16* WL = WH + 32 * 1024;
            for (int i = F.tid; i < 32768; i += NWAVES * 64) { const int k = i >> 5, e = i & 31; const float v = a.in[12][i]; const unsigned h16 = ab::cvtpk_s(v, 0.f) & 0xffffu; const float r = v - __uint_as_float(h16 << 16);
                WH[e * 1024 + k] = (bf16)h16; WL[e * 1024 + k] = (bf16)(ab::cvtpk_s(r, 0.f) & 0xffffu); }
        }
        if (F.bid == (F.G > 1 ? F.G - 2 : 0)) { float* WFT = (float*)(a.ws + WS_WFT);
            for (int col = F.tid; col < 1024; col += NWAVES * 64) { const float* p = a.in[6] + (size_t)col * INW + 3072; const f32x4 u = *(const f32x4*)p, w = *(const f32x4*)(p + 4);
                WFT[0 * 1024 + col] = u[0]; WFT[1 * 1024 + col] = u[1]; WFT[2 * 1024 + col] = u[2]; WFT[3 * 1024 + col] = u[3];
                WFT[4 * 1024 + col] = w[0]; WFT[5 * 1024 + col] = w[1]; WFT[6 * 1024 + col] = w[2]; WFT[7 * 1024 + col] = w[3]; } }
        for (int cb = F.bid; cb < 192; cb += F.G) {
            const int col = cb * 32 + (F.lane & 31), kh = F.lane >> 5;
            float acc = 0.f; float wv[64];
#pragma unroll
            for (int i = 0; i < 64; ++i) wv[i] = __builtin_nontemporal_load(W + (size_t)(F.wave * 128 + 2 * i + kh) * 6144 + col);
#pragma unroll
            for (int i = 0; i < 64; ++i) { const float cv = cvec[F.wave * 128 + 2 * i + kh]; acc += (cv / (1.0f + __expf(-cv))) * wv[i]; }
            acc += __shfl_xor(acc, 32);
            if (F.lane < 32) red[F.wave * 32 + F.lane] = acc;
            __syncthreads();
            if (F.tid < 32) { float s = 0.f;
#pragma unroll
                for (int w = 0; w < 8; ++w) s += red[w * 32 + F.tid];
                mod[cb * 32 + F.tid] = s + a.in[3][cb * 32 + F.tid]; }
            __syncthreads();
        }
    }
    {
        LAS float* scr = (LAS float*)(F.lds + (F.wave < 7 ? F.wave * 16640 : X_OFF));
        const int ngu = side_gu(F.G) ? 0 : 2048, nitems = CVT_NITEMS - 2048 + ngu;
        const int per = (nitems + F.G - 1) / F.G;
        const int it0 = F.bid * per, it1 = (it0 + per < nitems) ? it0 + per : nitems;
        const int n4 = (F.lane & 15) * 4, kr = F.lane >> 4, kg8 = F.lane & 7, nn = F.lane >> 3;
        f32x4 va[16], vb[16]; CvtItem ca, cb;
#define CVT_LOAD(vv, cc, ii) do { if ((ii) < it1) { cc = cvt_decode(a, (ii), F.wave, ngu); _Pragma("unroll") for (int p = 0; p < 16; ++p) vv[p] = __builtin_nontemporal_load((const f32x4*)(cc.src + (size_t)(kr + 4 * p) * cc.ldn + n4)); } } while (0)
#define CVT_ITEM(vv, cc, ii) do { \
            _Pragma("unroll") for (int p = 0; p < 16; ++p) { LAS float* s_ = scr + (kr + 4 * p) * 65 + n4; s_[0] = vv[p][0]; s_[1] = vv[p][1]; s_[2] = vv[p][2]; s_[3] = vv[p][3]; } \
            unsigned char* dst_ = cc.dst; const int esz_ = cc.esz; ii += 2; CVT_LOAD(vv, cc, ii); \
            asm volatile("s_waitcnt lgkmcnt(0)" ::: "memory"); \
            _Pragma("unroll") for (int q = 0; q < 8; ++q) { const int n_ = nn + 8 * q; const LAS float* s_ = scr + (8 * kg8) * 65 + n_; \
                if (esz_ == 2) { u32x4 o_; o_.x = ab::cvtpk_s(s_[0], s_[65]); o_.y = ab::cvtpk_s(s_[130], s_[195]); o_.z = ab::cvtpk_s(s_[260], s_[325]); o_.w = ab::cvtpk_s(s_[390], s_[455]); \
                    *(u32x4*)(dst_ + ((size_t)n_ * 1024 + 8 * kg8) * 2) = o_; } \
                else { u32x2 o_; o_.x = f8pk4(s_[0] * S_W, s_[65] * S_W, s_[130] * S_W, s_[195] * S_W); o_.y = f8pk4(s_[260] * S_W, s_[325] * S_W, s_[390] * S_W, s_[455] * S_W); \
                    *(u32x2*)(dst_ + (size_t)n_ * 1024 + 8 * kg8) = o_; } } \
            asm volatile("s_waitcnt lgkmcnt(0)" ::: "memory"); } while (0)
        int ita = it0, itb = it0 + 1;
        CVT_LOAD(va, ca, ita); CVT_LOAD(vb, cb, itb);
        while (ita < it1) {
            CVT_ITEM(va, ca, ita);
            if (itb < it1) CVT_ITEM(vb, cb, itb);
        }
#undef CVT_LOAD
#undef CVT_ITEM
        __syncthreads();
    }
}

__device__ __forceinline__ void phase1(const Args& a, Frame& F) {
    const float* mod = (const float*)(a.ws + WS_MOD);
    LAS float* wfT = (LAS float*)F.lds;
    LAS float* totw = (LAS float*)(F.lds + 32768);
    { const f32x4* WFT = (const f32x4*)(a.ws + WS_WFT); f32x4 wv[4];
#pragma unroll
      for (int i = 0; i < 4; ++i) wv[i] = WFT[F.tid + 512 * i];
#pragma unroll
      for (int i = 0; i < 4; ++i) *(LAS f32x4*)(wfT + 4 * (F.tid + 512 * i)) = wv[i]; }
    f32x4 A[4], B[4];
#pragma unroll
    for (int j = 0; j < 4; ++j) { const int c = 256 * j + 4 * F.lane; const f32x4 g = *(const f32x4*)(a.in[4] + c), sc = *(const f32x4*)(mod + 1024 + c); A[j] = g * (sc + 1.0f); B[j] = *(const f32x4*)(mod + c); }
    const float bfg = a.in[7][F.lane >> 3];
    __syncthreads();
    bf16* __restrict__ XN = (bf16*)(a.ws + WS_XN); float* __restrict__ LOGF = (float*)(a.ws + WS_LOGF); float* TOT = (float*)(a.ws + WS_TOT);
    const float* __restrict__ xin = a.in[0];
    for (int c_ = F.bid; c_ < NCHUNK; c_ += F.G) { const int c = vchunk(c_, F.G);
        float tot = 0.f;
#pragma unroll 2
        for (int rr = 0; rr < 8; ++rr) {
            const int row = c * CHR + F.wave * 8 + rr;
            const float* __restrict__ xr = xin + (size_t)row * DM + 4 * F.lane;
            f32x4 v[4]; float ss = 0.f;
#pragma unroll
            for (int j = 0; j < 4; ++j) { v[j] = __builtin_nontemporal_load((const f32x4*)(xr + 256 * j)); ss += (v[j][0] * v[j][0] + v[j][1] * v[j][1]) + (v[j][2] * v[j][2] + v[j][3] * v[j][3]); }
            const float rstd = 1.0f / sqrtf(wave_sum(ss) * (1.0f / DM) + RMS_EPS);
            bf16* orow = XN + (size_t)row * DM + 4 * F.lane;
#pragma unroll
            for (int j = 0; j < 4; ++j) { v[j] = (v[j] * rstd) * A[j] + B[j]; u32x2 o; o.x = ab::cvtpk_s(v[j][0], v[j][1]); o.y = ab::cvtpk_s(v[j][2], v[j][3]); *(u32x2*)(orow + 256 * j) = o; }
            float pe[8];
#pragma unroll
            for (int e = 0; e < 8; ++e) { float s = 0.f;
#pragma unroll
                for (int j = 0; j < 4; ++j) { const f32x4 w = *(const LAS f32x4*)(wfT + e * 1024 + 256 * j + 4 * F.lane); s += (v[j][0] * w[0] + v[j][1] * w[1]) + (v[j][2] * w[2] + v[j][3] * w[3]); }
                pe[e] = s; }
            float q4[4], q2[2];
            { const int b5 = F.lane >> 5, b4 = (F.lane >> 4) & 1, b3 = (F.lane >> 3) & 1;
#pragma unroll
              for (int i = 0; i < 4; ++i) { const float send = b5 ? pe[i] : pe[4 + i], keep = b5 ? pe[4 + i] : pe[i]; q4[i] = keep + __shfl_xor(send, 32); }
#pragma unroll
              for (int i = 0; i < 2; ++i) { const float send = b4 ? q4[i] : q4[2 + i], keep = b4 ? q4[2 + i] : q4[i]; q2[i] = keep + __shfl_xor(send, 16); }
              const float send = b3 ? q2[0] : q2[1], keep = b3 ? q2[1] : q2[0]; float z = keep + __shfl_xor(send, 8);
              z += __shfl_xor(z, 4); z += __shfl_xor(z, 2); z += __shfl_xor(z, 1);
              z += bfg;
              const float lf = fminf(z, 0.f) - log1pf(expf(-fabsf(z)));
              if ((F.lane & 7) == 0) { LOGF[(size_t)row * 8 + (F.lane >> 3)] = lf; tot += lf; } }
        }
        if ((F.lane & 7) == 0) totw[F.wave * 8 + (F.lane >> 3)] = tot;
        __syncthreads();
        if (F.tid < 8) { float s = 0.f;
#pragma unroll
            for (int w = 0; w < 8; ++w) s += totw[w * 8 + F.tid];
            TOT[c * 8 + F.tid] = s; }
        __syncthreads();
    }
}

__device__ __forceinline__ void cum_chunks(const Args& a, Frame& F) {
    const float* LOGF = (const float*)(a.ws + WS_LOGF); const float* TOT = (const float*)(a.ws + WS_TOT); float* CUM = (float*)(a.ws + WS_CUM);
    for (int c_ = F.bid; c_ < NCHUNK; c_ += F.G) { const int c = vchunk(c_, F.G);
        const int h = F.wave;
        double s = 0.0;
#pragma unroll
        for (int i = 0; i < 4; ++i) { const int cc = F.lane + 64 * i; if (cc < c) s += (double)TOT[cc * 8 + h]; }
        s = wave_sum_d(s);
        float x = LOGF[(size_t)(c * CHR + F.lane) * 8 + h];
#pragma unroll
        for (int o = 1; o < 64; o <<= 1) { const float y = __shfl_up(x, o); if (F.lane >= o) x += y; }
        CUM[(size_t)(c * CHR + F.lane) * 8 + h] = (float)(s + (double)x);
    }
}

__device__ __forceinline__ void qkt2(f32x16& p0, f32x16& p1, LAS const unsigned char* kslot, const bf16x8* qr, const f32x16& c0, const f32x16& c1, int r32, int hi) {
    LAS const unsigned char* kb = kslot + hi * 1024 + r32 * 16;
#pragma unroll
    for (int d0 = 0; d0 < 4; ++d0) {
        const bf16x8 b0 = *(LAS const bf16x8*)(kb + d0 * 2048), b1 = *(LAS const bf16x8*)(kb + d0 * 2048 + 512);
        if (d0 == 0) { p0 = __builtin_amdgcn_mfma_f32_32x32x16_bf16(b0, qr[0], c0, 0, 0, 0); p1 = __builtin_amdgcn_mfma_f32_32x32x16_bf16(b1, qr[0], c1, 0, 0, 0); }
        else { p0 = __builtin_amdgcn_mfma_f32_32x32x16_bf16(b0, qr[d0], p0, 0, 0, 0); p1 = __builtin_amdgcn_mfma_f32_32x32x16_bf16(b1, qr[d0], p1, 0, 0, 0); }
    }
}
__device__ __forceinline__ float moff_of(float m) { return m > -1e29f ? m : 0.f; }
__device__ __forceinline__ void softmax_pv(f32x16& p0, f32x16& p1, float& m, float& l, f32x16 (&o)[2], LAS float* wsf, int vb, int r32, int hi) {
    asm volatile("s_nop 15\n\ts_nop 7" : "+v"(p0), "+v"(p1));
    const float rm = ab::rowmax(p0, p1);
    const bool first = !(m > -1e29f);
    const bool grow = first ? (rm > -1e29f) : (rm > 8.0f);
    if (__any(grow)) {
        const float dlt = grow ? rm : 0.f;
        const float mn = grow ? rm + moff_of(m) : m;
        const float f = __builtin_amdgcn_exp2f(m - mn);
        m = mn; l *= f;
#pragma unroll
        for (int r = 0; r < 16; ++r) { p0[r] -= dlt; p1[r] -= dlt; }
        asm volatile("" ::: "memory");
        if (hi == 0) wsf[r32] = f;
        asm volatile("" ::: "memory");
#pragma unroll
        for (int g = 0; g < 4; ++g) { const f32x4 fr = *(LAS const f32x4*)(wsf + 8 * g + 4 * hi);
#pragma unroll
            for (int k = 0; k < 4; ++k) { o[0][4 * g + k] *= fr[k]; o[1][4 * g + k] *= fr[k]; } }
        asm volatile("" ::: "memory");
    }
    float s = 0.f;
#pragma unroll
    for (int r = 0; r < 16; ++r) { p0[r] = __builtin_amdgcn_exp2f(p0[r]); p1[r] = __builtin_amdgcn_exp2f(p1[r]); s += p0[r] + p1[r]; }
    l += s;
    u32x4 pw0, pw1, pw2, pw3;
    pw0 = (u32x4){ab::cvtpk_s(p0[0], p0[1]), ab::cvtpk_s(p0[2], p0[3]), ab::cvtpk_s(p0[4], p0[5]), ab::cvtpk_s(p0[6], p0[7])};
    pw1 = (u32x4){ab::cvtpk_s(p0[8], p0[9]), ab::cvtpk_s(p0[10], p0[11]), ab::cvtpk_s(p0[12], p0[13]), ab::cvtpk_s(p0[14], p0[15])};
    pw2 = (u32x4){ab::cvtpk_s(p1[0], p1[1]), ab::cvtpk_s(p1[2], p1[3]), ab::cvtpk_s(p1[4], p1[5]), ab::cvtpk_s(p1[6], p1[7])};
    pw3 = (u32x4){ab::cvtpk_s(p1[8], p1[9]), ab::cvtpk_s(p1[10], p1[11]), ab::cvtpk_s(p1[12], p1[13]), ab::cvtpk_s(p1[14], p1[15])};
    __builtin_amdgcn_sched_barrier(0);
    ab::pv(o, vb, __builtin_bit_cast(bf16x8, pw0), __builtin_bit_cast(bf16x8, pw1), __builtin_bit_cast(bf16x8, pw2), __builtin_bit_cast(bf16x8, pw3));
}
__device__ __forceinline__ void stage_o(const f32x16 (&o)[2], const float (&rli)[16], LAS bf16* stg, int r32, int hi) {
#pragma unroll
    for (int r = 0; r < 16; ++r) { const int orow = ab::crow(r, hi);
#pragma unroll
        for (int d0 = 0; d0 < 2; ++d0) stg[orow * 64 + d0 * 32 + r32] = (bf16)(ab::cvtpk_s(o[d0][r] * rli[r], 0.f) & 0xffffu); }
}

__device__ __forceinline__ void glds4(const void* gsrc, unsigned lds_dst) { unsigned keep;
    asm volatile("s_mov_b32 %0, m0\n\ts_mov_b32 m0, %2\n\ts_nop 0\n\tglobal_load_lds_dword %1, off\n\ts_mov_b32 m0, %0" : "=&s"(keep) : "v"(gsrc), "s"(lds_dst) : "memory"); }
__device__ __forceinline__ void fox_unit(const Args& a, Frame& F, int h, int qb) {
    const bf16* P = (const bf16*)(a.ws + WS_PROJ); const float* CUM = (const float*)(a.ws + WS_CUM);
    const int lane = F.lane, r32 = lane & 31, hi = lane >> 5, wid = F.wave, t0 = qb * 256;
    const float qn = __uint_as_float(__hip_atomic_load(F.ctl + CW_QN2H + (qb * 8 + h) * 2, RLX_AGENT)) + __uint_as_float(__hip_atomic_load(F.ctl + CW_QN2H + (qb * 8 + h) * 2 + 1, RLX_AGENT));
    const float kn = __uint_as_float(__hip_atomic_load(F.ctl + CW_KN2H + h * 2, RLX_AGENT)) + __uint_as_float(__hip_atomic_load(F.ctl + CW_KN2H + h * 2 + 1, RLX_AGENT));
    const float bnd = 2.0f * sqrtf(qn) * sqrtf(kn) * 1.01f + 0.05f;
    const float Ct0 = CUM[(size_t)t0 * 8 + h], Cref = CUM[(size_t)(t0 + 255) * 8 + h];
    int jmin = 0; bool found = false;
    for (int base = 4 * qb - 1; base >= 0 && !found; base -= 64) {
        const int j = base - lane; bool need = false;
        if (j >= 0) need = (bnd + (Ct0 - CUM[(size_t)(64 * j + 63) * 8 + h]) * LOG2E) >= -44.5f;
        const unsigned long long mk = __ballot(need);
        if (mk == 0ull) { jmin = base + 1; found = true; }
        else { const int hb = 63 - __builtin_clzll(mk); if (hb < 63) { jmin = base - hb; found = true; } }
    }
    jmin = __builtin_amdgcn_readfirstlane(jmin);
    const int NT = 4 * qb + 4, nt = NT - jmin;
    const bf16* Qw = P + (size_t)(t0 + wid * 32 + r32) * PITCH + OFF_QA + h * 64;
    bf16x8 qr[4];
#pragma unroll
    for (int d0 = 0; d0 < 4; ++d0) qr[d0] = *(const bf16x8*)(Qw + d0 * 16 + hi * 8);
    float m = -1e30f, l = 0.f; f32x16 o[2]; o[0] = f32x16{}; o[1] = f32x16{};
    const bf16* ksrc = P + OFF_KA + h * 64 + (size_t)lane * PITCH + wid * 8;
    const bf16* vsrc = P + OFF_VA + h * 64 + (size_t)(16 * (wid & 3) + (lane >> 2)) * PITCH + (wid >> 2) * 32 + (lane & 3) * 8;
    const float* csrc = CUM + (size_t)lane * 8 + h;
    const unsigned kdst = lds_addr(F.lds + A_K) + wid * 1024, vdst = lds_addr(F.lds + A_V) + wid * 1024, cdst = lds_addr(F.lds + X_OFF + 8192);
    LAS const float* cring = (LAS const float*)(F.lds + X_OFF + 8192); LAS float* wsf = (LAS float*)(F.lds + A_WS) + wid * 64;
    const int vb = (int)lds_addr(F.lds + A_V) + ((lane >> 4) & 1) * 32 + (lane & 3) * 8 + (4 * hi + ((lane & 15) >> 2)) * 64;
#define FOX_ISSUE(i_) do { const int j_ = jmin + (i_); const unsigned so_ = (unsigned)((i_) & 3); \
        ab::glds16(ksrc + (size_t)j_ * 64 * PITCH, (unsigned)__builtin_amdgcn_readfirstlane(kdst + so_ * 8192)); ab::glds16(vsrc + (size_t)j_ * 64 * PITCH, (unsigned)__builtin_amdgcn_readfirstlane(vdst + so_ * 8192)); \
        if (wid == 0) glds4(csrc + (size_t)j_ * 64 * 8, (unsigned)__builtin_amdgcn_readfirstlane(cdst + so_ * 256)); } while (0)
    __syncthreads();
    FOX_ISSUE(0); if (nt > 1) FOX_ISSUE(1); if (nt > 2) FOX_ISSUE(2);
    for (int i = 0; i < nt; ++i) {
        const int ahead = (nt - 1 - i) < 2 ? (nt - 1 - i) : 2;
        if (wid == 0) { if (ahead == 2) asm volatile("s_waitcnt vmcnt(6)" ::: "memory"); else if (ahead == 1) asm volatile("s_waitcnt vmcnt(3)" ::: "memory"); else asm volatile("s_waitcnt vmcnt(0)" ::: "memory"); }
        else { if (ahead == 2) asm volatile("s_waitcnt vmcnt(4)" ::: "memory"); else if (ahead == 1) asm volatile("s_waitcnt vmcnt(2)" ::: "memory"); else asm volatile("s_waitcnt vmcnt(0)" ::: "memory"); }
        __syncthreads();
        if (i + 3 < nt) FOX_ISSUE(i + 3);
        const int so = i & 3, j = jmin + i;
        f32x16 c0, c1; const float crl = Cref * LOG2E - moff_of(m);
#pragma unroll
        for (int g = 0; g < 4; ++g) { const f32x4 b0 = *(LAS const f32x4*)(cring + so * 64 + 8 * g + 4 * hi), b1 = *(LAS const f32x4*)(cring + so * 64 + 32 + 8 * g + 4 * hi);
#pragma unroll
            for (int k = 0; k < 4; ++k) { c0[4 * g + k] = __builtin_fmaf(b0[k], -LOG2E, crl); c1[4 * g + k] = __builtin_fmaf(b1[k], -LOG2E, crl); } }
        f32x16 p0, p1;
        qkt2(p0, p1, F.lds + A_K + so * 8192, qr, c0, c1, r32, hi);
        const int jb = j - (NT - 4);
        if (jb >= 0) ab::cmask(p0, p1, jb, wid * 32 + r32, hi);
        softmax_pv(p0, p1, m, l, o, wsf, vb + so * 8192, r32, hi);
    }
#undef FOX_ISSUE
    { auto rr = __builtin_amdgcn_permlane32_swap(__float_as_uint(l), __float_as_uint(l), false, false); l = __uint_as_float(rr[0]) + __uint_as_float(rr[1]); }
    asm volatile("" ::: "memory");
    if (hi == 0) wsf[32 + r32] = l;
    asm volatile("" ::: "memory");
    float rli[16];
#pragma unroll
    for (int r = 0; r < 16; ++r) rli[r] = __builtin_amdgcn_rcpf(wsf[32 + ab::crow(r, hi)]);
    LAS bf16* stg = (LAS bf16*)(F.lds + A_OST) + wid * 2048;
    stage_o(o, rli, stg, r32, hi);
    asm volatile("s_waitcnt lgkmcnt(0)" ::: "memory");
    bf16* Ow = (bf16*)(a.ws + WS_MIX) + (size_t)(t0 + wid * 32) * DM + h * 64;
#pragma unroll
    for (int i = 0; i < 4; ++i) { const int row = i * 8 + (lane >> 3), ch = lane & 7; const u32x4 v = *(LAS const u32x4*)(stg + row * 64 + ch * 8); *(u32x4*)(Ow + (size_t)row * DM + ch * 8) = v; }
}

__device__ __forceinline__ void moba_build_kmean(const Args& a, Frame& F) {
    const float* KMS = (const float*)(F.ctl + CW_KMS);
    const int h = F.tid >> 6, d = F.tid & 63;
    LAS bf16* km = (LAS bf16*)(F.lds + h * 8192 + (d >> 3) * 1024 + (d & 7) * 2);
    float sv[NMB];
#pragma unroll
    for (int n = 0; n < NMB; ++n) sv[n] = KMS[((size_t)h * 64 + n) * 64 + d];
#pragma unroll
    for (int n = 0; n < NMB; ++n) { const float s = sv[n] * (1.0f / 256.0f); km[n * 8] = (bf16)(ab::cvtpk_s(s, 0.f) & 0xffffu); }
    __syncthreads();
}
#define TOP3_INS(g, n) do { const float g_ = (g); const int n_ = (n); \
    if (g_ > v1 || (g_ == v1 && n_ < i1)) { v3 = v2; i3 = i2; v2 = v1; i2 = i1; v1 = g_; i1 = n_; } \
    else if (g_ > v2 || (g_ == v2 && n_ < i2)) { v3 = v2; i3 = i2; v2 = g_; i2 = n_; } \
    else if (g_ > v3 || (g_ == v3 && n_ < i3)) { v3 = g_; i3 = n_; } } while (0)
__device__ __forceinline__ void moba_gate_task(const Args& a, Frame& F, int h, int t0, int own) {
    const bf16* P = (const bf16*)(a.ws + WS_PROJ);
    const int lane = F.lane, r32 = lane & 31, hi = lane >> 5, t = t0 + r32;
    bf16x8 qr[4];
    { const bf16* Qw = P + (size_t)t * PITCH + OFF_QB + h * 64;
#pragma unroll
      for (int d0 = 0; d0 < 4; ++d0) qr[d0] = *(const bf16x8*)(Qw + d0 * 16 + hi * 8); }
    f32x16 z;
#pragma unroll
    for (int r = 0; r < 16; ++r) z[r] = 0.f;
    f32x16 p0, p1;
    qkt2(p0, p1, F.lds + h * 8192, qr, z, z, r32, hi);
    float v1 = -INFINITY, v2 = -INFINITY, v3 = -INFINITY; int i1 = 1 << 20, i2 = 1 << 20, i3 = 1 << 20;
#pragma unroll
    for (int r = 0; r < 16; ++r) { const int n = ab::crow(r, hi); const float g = n < own ? p0[r] : -INFINITY; if (g > -INFINITY) TOP3_INS(g, n); }
#pragma unroll
    for (int r = 0; r < 16; ++r) { const int n = 32 + ab::crow(r, hi); const float g = n < own ? p1[r] : -INFINITY; if (g > -INFINITY) TOP3_INS(g, n); }
    { const float w1 = __shfl_xor(v1, 32), w2 = __shfl_xor(v2, 32), w3 = __shfl_xor(v3, 32); const int j1 = __shfl_xor(i1, 32), j2 = __shfl_xor(i2, 32), j3 = __shfl_xor(i3, 32);
      if (w1 > -INFINITY) TOP3_INS(w1, j1);
      if (w2 > -INFINITY) TOP3_INS(w2, j2);
      if (w3 > -INFINITY) TOP3_INS(w3, j3); }
    if (v1 == -INFINITY) i1 = -1;
    if (v2 == -INFINITY) i2 = -1;
    if (v3 == -INFINITY) i3 = -1;
    LAS int* cnt = (LAS int*)(F.lds + X_OFF) + F.wave * 128; LAS int* gb = cnt + 64;
    cnt[lane] = 0;
    asm volatile("s_waitcnt lgkmcnt(0)" ::: "memory");
    int r1 = 0, r2 = 0, r3 = 0;
    if (hi == 0) {
        if (i1 >= 0) r1 = (int)__hip_atomic_fetch_add(cnt + i1, 1, __ATOMIC_RELAXED, __HIP_MEMORY_SCOPE_WORKGROUP);
        if (i2 >= 0) r2 = (int)__hip_atomic_fetch_add(cnt + i2, 1, __ATOMIC_RELAXED, __HIP_MEMORY_SCOPE_WORKGROUP);
        if (i3 >= 0) r3 = (int)__hip_atomic_fetch_add(cnt + i3, 1, __ATOMIC_RELAXED, __HIP_MEMORY_SCOPE_WORKGROUP);
    }
    asm volatile("s_waitcnt lgkmcnt(0)" ::: "memory");
    { const int cn = cnt[lane]; int b = 0; if (cn > 0) b = (int)__hip_atomic_fetch_add((unsigned*)(F.ctl + CW_GCNT + h * 64 + lane), (unsigned)cn, __ATOMIC_RELAXED, __HIP_MEMORY_SCOPE_AGENT); gb[lane] = b; }
    asm volatile("s_waitcnt vmcnt(0) lgkmcnt(0)" ::: "memory");
    if (hi == 0) {
        int* ML = (int*)(a.ws + WS_MLIST) + (size_t)h * LCAP;
        if (i1 >= 0) ML[256 * (63 * i1 - (i1 * (i1 - 1)) / 2) + gb[i1] + r1] = t * 4 + 0;
        if (i2 >= 0) ML[256 * (63 * i2 - (i2 * (i2 - 1)) / 2) + gb[i2] + r2] = t * 4 + 1;
        if (i3 >= 0) ML[256 * (63 * i3 - (i3 * (i3 - 1)) / 2) + gb[i3] + r3] = t * 4 + 2;
    }
    asm volatile("s_waitcnt lgkmcnt(0)" ::: "memory");
}

constexpr int A_LUT4 = 121600, LUT4_STRIDE = 2080;
static_assert(A_LUT4 + 4 * LUT4_STRIDE <= RING_BYTES && A_LUT4 >= 116992 + (520 + 512) * 4, "LUT4 inside the ring region, behind the prefix table");
__device__ __forceinline__ void build_lut4(Frame& F, int h) {
    LAS const float* lut = (LAS const float*)(F.lds + A_LUT) + h * 512; LAS float* c = (LAS float*)(F.lds + A_LUT4);
    for (int i = F.tid; i < 4 * 520; i += NWAVES * 64) { const int s_ = i / 520, j = i - s_ * 520; const int x = j + s_ - 4; c[s_ * 520 + j] = lut[min(max(x, 0), 511)]; }
}
template <bool MASK>
__device__ __forceinline__ void near_bias(f32x16& p0, f32x16& p1, LAS const unsigned char* lds, int D) {
#pragma unroll
    for (int g = 0; g < 4; ++g)
#pragma unroll
        for (int half = 0; half < 2; ++half) {
            const int E = D - 8 * g - 3 - 32 * half, Ec = min(max(E, -4), 508);
            const f32x4 q = *(LAS const f32x4*)(lds + A_LUT4 + (Ec & 3) * LUT4_STRIDE + ((Ec & ~3) + 4) * 4);
#pragma unroll
            for (int ii = 0; ii < 4; ++ii) { const int r = 4 * g + ii; const float b = q[3 - ii];
                if (half == 0) p0[r] = (MASK && (E + 3 - ii) < 0) ? -INFINITY : p0[r] + b; else p1[r] = (MASK && (E + 3 - ii) < 0) ? -INFINITY : p1[r] + b; } }
}
__device__ __forceinline__ void moba_item(const Args& a, Frame& F, int h, int n, bool own, const int* list, int cnt) {
    const bf16* P = (const bf16*)(a.ws + WS_PROJ);
    const int lane = F.lane, r32 = lane & 31, hi = lane >> 5, wid = F.wave;
    __syncthreads();
    { const bf16* ksrc = P + OFF_KB + h * 64 + (size_t)(256 * n + lane) * PITCH + wid * 8;
      const bf16* vsrc = P + OFF_VB + h * 64 + (size_t)(256 * n + 16 * (wid & 3) + (lane >> 2)) * PITCH + (wid >> 2) * 32 + (lane & 3) * 8;
      const unsigned kdst = lds_addr(F.lds + A_K) + wid * 1024, vdst = lds_addr(F.lds + A_V) + wid * 1024;
#pragma unroll
      for (int jt = 0; jt < 4; ++jt) { ab::glds16(ksrc + (size_t)jt * 64 * PITCH, (unsigned)__builtin_amdgcn_readfirstlane(kdst + jt * 8192)); ab::glds16(vsrc + (size_t)jt * 64 * PITCH, (unsigned)__builtin_amdgcn_readfirstlane(vdst + jt * 8192)); } }
    int nv = cnt - wid * 32; nv = nv < 0 ? 0 : (nv > 32 ? 32 : nv);
    int ent;
    if (own) ent = ((256 * n + wid * 32 + r32) << 2) | 3;
    else { int idx = wid * 32 + r32; if (idx >= cnt) idx = cnt - 1; ent = list[idx]; }
    const int t = ent >> 2;
    bf16x8 qr[4];
    { const bf16* Qw = P + (size_t)t * PITCH + OFF_QB + h * 64;
#pragma unroll
      for (int d0 = 0; d0 < 4; ++d0) qr[d0] = *(const bf16x8*)(Qw + d0 * 16 + hi * 8); }
    build_lut4(F, h);
    asm volatile("s_waitcnt vmcnt(0) lgkmcnt(0)" ::: "memory");
    __syncthreads();
    if (nv > 0) {
        LAS const float* lut = (LAS const float*)(F.lds + A_LUT) + h * 512;
        LAS float* wsf = (LAS float*)(F.lds + A_WS) + wid * 64;
        const bool anynear = __any(t < 256 * (n + 2)) != 0;
        const float rb31 = lut[511];
        float m = -1e30f, l = 0.f; f32x16 o[2]; o[0] = f32x16{}; o[1] = f32x16{};
        const int vb0 = (int)lds_addr(F.lds + A_V) + ((lane >> 4) & 1) * 32 + (lane & 3) * 8 + (4 * hi + ((lane & 15) >> 2)) * 64;
        for (int jt = 0; jt < 4; ++jt) {
            if (own && 64 * jt > wid * 32 + 31) break;
            f32x16 cc;
            const bool near_t = anynear && __any(t < 256 * n + 64 * jt + 63 + 113) != 0;
            const float ci = (near_t ? 0.f : rb31) - moff_of(m);
#pragma unroll
            for (int r = 0; r < 16; ++r) cc[r] = ci;
            f32x16 p0, p1;
            qkt2(p0, p1, F.lds + A_K + jt * 8192, qr, cc, cc, r32, hi);
            if (near_t) { const int D = t - (256 * n + 64 * jt + 4 * hi);
                if (!own || 64 * jt + 63 > wid * 32) near_bias<true>(p0, p1, F.lds, D); else near_bias<false>(p0, p1, F.lds, D); }
            softmax_pv(p0, p1, m, l, o, wsf, vb0 + jt * 8192, r32, hi);
        }
        { auto rr = __builtin_amdgcn_permlane32_swap(__float_as_uint(l), __float_as_uint(l), false, false); l = __uint_as_float(rr[0]) + __uint_as_float(rr[1]); }
        float rli[16];
#pragma unroll
        for (int r = 0; r < 16; ++r) rli[r] = 1.0f;
        LAS bf16* stg = (LAS bf16*)(F.lds + A_OST) + wid * 2048;
        stage_o(o, rli, stg, r32, hi);
        asm volatile("s_waitcnt lgkmcnt(0)" ::: "memory");
        const bf16* PO = (const bf16*)(a.ws + WS_PO); const float* PM = (const float*)(a.ws + WS_PM); const float* PL = (const float*)(a.ws + WS_PL);
        bf16* MIX = (bf16*)(a.ws + WS_MIX);
        const int nsel = n < 3 ? n : 3;
        float mi[4][3], li[4][3]; u32x4 pv_[4][3];
#pragma unroll
        for (int i = 0; i < 4; ++i) { const int row = i * 8 + (lane >> 3), ch = lane & 7; const int tr = 256 * n + wid * 32 + row; const size_t pb = (size_t)(tr * 8 + h) * 4;
#pragma unroll
            for (int k = 0; k < 3; ++k) { const bool valid = k < nsel; mi[i][k] = valid ? PM[pb + k] : -INFINITY; li[i][k] = valid ? PL[pb + k] : 0.f; pv_[i][k] = valid ? __builtin_nontemporal_load((const u32x4*)(PO + (pb + k) * 64 + ch * 8)) : (u32x4){0u, 0u, 0u, 0u}; } }
#pragma unroll
        for (int i = 0; i < 4; ++i) { const int row = i * 8 + (lane >> 3), ch = lane & 7; const int tr = 256 * n + wid * 32 + row;
            const float mo = __shfl(m, row), lo_ = __shfl(l, row);
            const u32x4 v = *(LAS const u32x4*)(stg + row * 64 + ch * 8);
            float M = mo;
#pragma unroll
            for (int k = 0; k < 3; ++k) M = fmaxf(M, mi[i][k]);
            const float wo = __builtin_amdgcn_exp2f(mo - M); float L = wo * lo_; float acc[8];
#pragma unroll
            for (int k = 0; k < 4; ++k) { acc[2 * k] = wo * __uint_as_float(v[k] << 16); acc[2 * k + 1] = wo * __uint_as_float(v[k] & 0xffff0000u); }
#pragma unroll
            for (int k = 0; k < 3; ++k) { const float w = __builtin_amdgcn_exp2f(mi[i][k] - M); L += w * li[i][k];
#pragma unroll
                for (int q = 0; q < 4; ++q) { acc[2 * q] += w * __uint_as_float(pv_[i][k][q] << 16); acc[2 * q + 1] += w * __uint_as_float(pv_[i][k][q] & 0xffff0000u); } }
            const float inv = 1.0f / L;
            u32x4 ov; ov.x = ab::cvtpk_s(acc[0] * inv, acc[1] * inv); ov.y = ab::cvtpk_s(acc[2] * inv, acc[3] * inv); ov.z = ab::cvtpk_s(acc[4] * inv, acc[5] * inv); ov.w = ab::cvtpk_s(acc[6] * inv, acc[7] * inv);
            *(u32x4*)(MIX + (size_t)tr * DM + 512 + h * 64 + ch * 8) = ov; }
    }
}

__device__ __forceinline__ void build_lut(const Args& a, Frame& F) {
    LAS float* lut = (LAS float*)(F.lds + A_LUT);
    for (int i = F.tid; i < 8 * 512; i += NWAVES * 64) { const int h = i >> 9, d = i & 511; lut[i] = a.in[8][t5_bucket(d) * 8 + h] * LOG2E; }
    __syncthreads();
}
__device__ __forceinline__ void phase4(const Args& a, Frame& F) {
    moba_build_kmean(a, F);
    for (int c_ = F.bid; c_ < NCHUNK; c_ += F.G) { const int c = c_; const int own = c >> 2;
        if (own > 0) { moba_gate_task(a, F, F.wave, c * CHR, own); moba_gate_task(a, F, F.wave, c * CHR + 32, own); } }
    __syncthreads();
    for (int u = F.bid; u < NH * 64; u += F.G) fox_unit(a, F, u & 7, u >> 3);
}
struct RItem { int pi, cnt; const int* list; };
__device__ __forceinline__ RItem p5_decode(const Args& a, Frame& F, LAS const int* pfx, int it, int from) {
    int lo = 0, hi = 512;
    if (from >= 0) { lo = from; while (pfx[lo + 1] <= it) ++lo; }
    else while (hi - lo > 1) { const int mid = (lo + hi) >> 1; if (pfx[mid] <= it) lo = mid; else hi = mid; }
    RItem r; r.pi = __builtin_amdgcn_readfirstlane(lo); const int g = it - __builtin_amdgcn_readfirstlane(pfx[lo]), h = r.pi >> 6, n = r.pi & 63;
    const int total = __builtin_amdgcn_readfirstlane(pfx[520 + r.pi]);
    int cnt = total - g * 256; r.cnt = cnt > 256 ? 256 : cnt;
    r.list = (const int*)(a.ws + WS_MLIST) + (size_t)h * LCAP + 256 * (63 * n - (n * (n - 1)) / 2) + g * 256;
    return r;
}
__device__ __forceinline__ int p5_ent(const RItem& r, int wid, int r32) { int idx = wid * 32 + r32; if (idx >= r.cnt) idx = r.cnt - 1; return r.list[idx]; }
__device__ __forceinline__ void p5_q(bf16x8 (&qr)[4], const bf16* P, int ent, int h, int hi) {
    const bf16* Qw = P + (size_t)(ent >> 2) * PITCH + OFF_QB + h * 64;
#pragma unroll
    for (int d0 = 0; d0 < 4; ++d0) qr[d0] = *(const bf16x8*)(Qw + d0 * 16 + hi * 8);
}
__device__ __forceinline__ void phase5(const Args& a, Frame& F) {
    build_lut(a, F);
    LAS int* pfx = (LAS int*)(F.lds + A_PFX); LAS int* wt = (LAS int*)(F.lds + X_OFF);
    const int gc = (int)__hip_atomic_load(F.ctl + CW_GCNT + F.tid, RLX_AGENT);
    { int v = (gc + 255) >> 8;
#pragma unroll
      for (int o = 1; o < 64; o <<= 1) { const int y = __shfl_up(v, o); if (F.lane >= o) v += y; }
      if (F.lane == 63) wt[F.wave] = v;
      __syncthreads();
      int off = 0;
      for (int w = 0; w < F.wave; ++w) off += wt[w];
      pfx[F.tid + 1] = off + v; pfx[520 + F.tid] = gc; if (F.tid == 0) pfx[0] = 0;
      __syncthreads(); }
    const int nitems = pfx[512], per = (nitems + F.G - 1) / F.G, it0 = F.bid * per, it1 = (it0 + per < nitems) ? it0 + per : nitems;
    if (it0 >= it1) return;
    const bf16* P = (const bf16*)(a.ws + WS_PROJ);
    const int lane = F.lane, r32 = lane & 31, hi = lane >> 5, wid = F.wave;
    LAS float* wsf = (LAS float*)(F.lds + A_WS) + wid * 64;
    LAS bf16* stg = (LAS bf16*)(F.lds + A_OST) + wid * 2048;
    const int vb0 = (int)lds_addr(F.lds + A_V) + ((lane >> 4) & 1) * 32 + (lane & 3) * 8 + (4 * hi + ((lane & 15) >> 2)) * 64;
    bf16* PO = (bf16*)(a.ws + WS_PO); float* PM = (float*)(a.ws + WS_PM); float* PL = (float*)(a.ws + WS_PL);
    RItem cur = p5_decode(a, F, pfx, it0, -1), nx = cur;
    int ent = p5_ent(cur, wid, r32), ent_n = ent; bf16x8 qr[4], qn[4];
    p5_q(qr, P, ent, cur.pi >> 6, hi);
    int staged = -1;
    for (int it = it0; it < it1; ++it) {
        const bool has_next = it + 1 < it1;
        if (has_next) { nx = p5_decode(a, F, pfx, it + 1, cur.pi); ent_n = p5_ent(nx, wid, r32); }
        const int h = cur.pi >> 6, n = cur.pi & 63;
        if (cur.pi != staged) {
            __syncthreads();
            const bf16* ksrc = P + OFF_KB + h * 64 + (size_t)(256 * n + lane) * PITCH + wid * 8;
            const bf16* vsrc = P + OFF_VB + h * 64 + (size_t)(256 * n + 16 * (wid & 3) + (lane >> 2)) * PITCH + (wid >> 2) * 32 + (lane & 3) * 8;
            const unsigned kdst = lds_addr(F.lds + A_K) + wid * 1024, vdst = lds_addr(F.lds + A_V) + wid * 1024;
#pragma unroll
            for (int jt = 0; jt < 4; ++jt) { ab::glds16(ksrc + (size_t)jt * 64 * PITCH, (unsigned)__builtin_amdgcn_readfirstlane(kdst + jt * 8192)); ab::glds16(vsrc + (size_t)jt * 64 * PITCH, (unsigned)__builtin_amdgcn_readfirstlane(vdst + jt * 8192)); }
            build_lut4(F, h);
            asm volatile("s_waitcnt vmcnt(0) lgkmcnt(0)" ::: "memory");
            __syncthreads();
            staged = cur.pi;
        }
        int nv = cur.cnt - wid * 32; nv = nv < 0 ? 0 : (nv > 32 ? 32 : nv);
        const int t = ent >> 2;
        if (nv > 0) {
            LAS const float* lut = (LAS const float*)(F.lds + A_LUT) + h * 512;
            const bool anynear = __any(t < 256 * (n + 2)) != 0;
            const float rb31 = lut[511];
            float m = -1e30f, l = 0.f; f32x16 o[2]; o[0] = f32x16{}; o[1] = f32x16{};
#pragma unroll 1
            for (int jt = 0; jt < 4; ++jt) {
                const bool near_t = anynear && __any(t < 256 * n + 64 * jt + 63 + 113) != 0;
                f32x16 cc; const float ci = (near_t ? 0.f : rb31) - moff_of(m);
#pragma unroll
                for (int r = 0; r < 16; ++r) cc[r] = ci;
                f32x16 p0, p1;
                qkt2(p0, p1, F.lds + A_K + jt * 8192, qr, cc, cc, r32, hi);
                if (near_t) near_bias<false>(p0, p1, F.lds, t - (256 * n + 64 * jt + 4 * hi));
                softmax_pv(p0, p1, m, l, o, wsf, vb0 + jt * 8192, r32, hi);
                if (jt == 0 && has_next) p5_q(qn, P, ent_n, nx.pi >> 6, hi);
            }
            { auto rr = __builtin_amdgcn_permlane32_swap(__float_as_uint(l), __float_as_uint(l), false, false); l = __uint_as_float(rr[0]) + __uint_as_float(rr[1]); }
            float rli[16];
#pragma unroll
            for (int r = 0; r < 16; ++r) rli[r] = 1.0f;
            stage_o(o, rli, stg, r32, hi);
            asm volatile("s_waitcnt lgkmcnt(0)" ::: "memory");
#pragma unroll
            for (int i = 0; i < 4; ++i) { const int row = i * 8 + (lane >> 3), ch = lane & 7; const int er = __shfl(ent, row);
                const u32x4 v = *(LAS const u32x4*)(stg + row * 64 + ch * 8);
                if (row < nv) *(u32x4*)(PO + ((size_t)((er >> 2) * 8 + h) * 4 + (er & 3)) * 64 + ch * 8) = v; }
            if (hi == 0 && r32 < nv) { const size_t pi = (size_t)(t * 8 + h) * 4 + (ent & 3); PM[pi] = m; PL[pi] = l; }
            asm volatile("s_waitcnt lgkmcnt(0)" ::: "memory");
        } else if (has_next) p5_q(qn, P, ent_n, nx.pi >> 6, hi);
        cur = nx; ent = ent_n;
#pragma unroll
        for (int d0 = 0; d0 < 4; ++d0) qr[d0] = qn[d0];
    }
}
__device__ __forceinline__ void phase6(const Args& a, Frame& F, bool have_lut) {
    if (!have_lut) build_lut(a, F);
    for (int u = F.bid; u < NH * NMB; u += F.G) moba_item(a, F, u & 7, u >> 3, true, nullptr, 256);
}
__device__ __forceinline__ void phase8(const Args& a, Frame& F) {
    const float* mod = (const float*)(a.ws + WS_MOD);
    LAS float* part = (LAS float*)F.lds;
    LAS float* lg = (LAS float*)(F.lds + 65536);
    LAS int* hist = (LAS int*)(F.lds + X_OFF); LAS int* ebase = hist + 32; LAS int* rsel = hist + 64; LAS int* rrank = rsel + 256; LAS float* rgate = (LAS float*)(rrank + 256);
    const bf16* __restrict__ AO = (const bf16*)(a.ws + WS_AO);
    LAS unsigned char* LO = F.lds;
    const float* __restrict__ xin = a.in[0]; unsigned char* __restrict__ XN8 = a.ws + WS_XN8;
    const bf16* WH = (const bf16*)(a.ws + WS_WRT); const bf16* WL = WH + 32 * 1024;
    int* EIDX = (int*)(a.ws + WS_EIDX); float* GATE = (float*)(a.ws + WS_GATE); int* LOC = (int*)(a.ws + WS_LOC);
    const int lane = F.lane, r32 = lane & 31, hi = lane >> 5;
    LAS float* gv = (LAS float*)(F.lds + X_OFF + 4096);
    for (int i = F.tid; i < 1024; i += NWAVES * 64) { gv[i] = a.in[5][i] * mod[2048 + i]; gv[1024 + i] = a.in[10][i] * (mod[4096 + i] + 1.0f); gv[2048 + i] = mod[3072 + i]; }
    __syncthreads();
    for (int c_ = F.bid; c_ < NCHUNK; c_ += F.G) { const int c = vchunk(c_, F.G);
        if (F.tid < 32) hist[F.tid] = 0;
#pragma unroll 2
        for (int rr = 0; rr < 8; ++rr) {
            const int row = c * CHR + F.wave * 8 + rr;
            f32x4 y[4]; float ss = 0.f;
#pragma unroll
            for (int j = 0; j < 4; ++j) { const u32x2 v = __builtin_nontemporal_load((const u32x2*)(AO + (size_t)row * DM + 256 * j + 4 * lane));
                y[j] = (f32x4){__uint_as_float(v.x << 16), __uint_as_float(v.x & 0xffff0000u), __uint_as_float(v.y << 16), __uint_as_float(v.y & 0xffff0000u)};
                ss += (y[j][0] * y[j][0] + y[j][1] * y[j][1]) + (y[j][2] * y[j][2] + y[j][3] * y[j][3]); }
            const float rs1 = 1.0f / sqrtf(wave_sum(ss) * (1.0f / DM) + RMS_EPS);
            if (lane == 0) ((float*)(a.ws + WS_RS1))[row] = rs1;
            float ss2 = 0.f;
#pragma unroll
            for (int j = 0; j < 4; ++j) { const int cc = 256 * j + 4 * lane; const f32x4 xv = __builtin_nontemporal_load((const f32x4*)(xin + (size_t)row * DM + cc));
                const f32x4 ga = *(LAS const f32x4*)(gv + cc);
                y[j] = xv + (y[j] * rs1) * ga;
                ss2 += (y[j][0] * y[j][0] + y[j][1] * y[j][1]) + (y[j][2] * y[j][2] + y[j][3] * y[j][3]); }
            const float rs2 = 1.0f / sqrtf(wave_sum(ss2) * (1.0f / DM) + RMS_EPS);
#pragma unroll
            for (int j = 0; j < 4; ++j) { const int cc = 256 * j + 4 * lane;
                const f32x4 gb_ = *(LAS const f32x4*)(gv + 1024 + cc), gc_ = *(LAS const f32x4*)(gv + 2048 + cc);
                y[j] = (y[j] * rs2) * gb_ + gc_;
                const unsigned q8 = f8pk4(y[j][0] * S_A, y[j][1] * S_A, y[j][2] * S_A, y[j][3] * S_A); *(unsigned*)(XN8 + (size_t)row * DM + cc) = q8;
                const auto d0 = __builtin_amdgcn_cvt_pk_f32_fp8((int)q8, false), d1 = __builtin_amdgcn_cvt_pk_f32_fp8((int)q8, true);
                const f32x4 rsd = y[j] - (f32x4){d0[0], d0[1], d1[0], d1[1]} * (1.0f / S_A);
                u32x2 ol; ol.x = ab::cvtpk_s(rsd[0], rsd[1]); ol.y = ab::cvtpk_s(rsd[2], rsd[3]);
                { const int rl = F.wave * 8 + rr, ch = 32 * j + (lane >> 1); *(LAS u32x2*)(LO + rl * 2048 + ((ch ^ (rl & 15)) << 4) + ((lane & 1) << 3)) = ol; } }
        }
        bf16x8 wh[8], wl[8];
        { const bf16* bh = WH + (size_t)r32 * DM + F.wave * 128 + hi * 8; const bf16* bl = WL + (size_t)r32 * DM + F.wave * 128 + hi * 8;
#pragma unroll
          for (int ks = 0; ks < 8; ++ks) { wh[ks] = *(const bf16x8*)(bh + 16 * ks); wl[ks] = *(const bf16x8*)(bl + 16 * ks); } }
        asm volatile("s_waitcnt vmcnt(0)" ::: "memory");
        __syncthreads();
        {
            f32x16 acc[2]; acc[0] = f32x16{}; acc[1] = f32x16{};
            const unsigned char* ah = XN8 + (size_t)(c * CHR + r32) * DM + F.wave * 128 + hi * 8;
#pragma unroll
            for (int kq = 0; kq < 2; ++kq) {
                bf16x8 xh[2][4], xl[2][4];
#pragma unroll
                for (int k4 = 0; k4 < 4; ++k4)
#pragma unroll
                    for (int rt = 0; rt < 2; ++rt) { const u32x2 h8 = *(const u32x2*)(ah + (size_t)(32 * rt) * DM + 16 * (4 * kq + k4));
                        const auto e0 = __builtin_amdgcn_cvt_pk_f32_fp8((int)h8.x, false), e1 = __builtin_amdgcn_cvt_pk_f32_fp8((int)h8.x, true), e2 = __builtin_amdgcn_cvt_pk_f32_fp8((int)h8.y, false), e3 = __builtin_amdgcn_cvt_pk_f32_fp8((int)h8.y, true);
                        const u32x4 hb = (u32x4){ab::cvtpk_s(e0[0] * (1.0f / S_A), e0[1] * (1.0f / S_A)), ab::cvtpk_s(e1[0] * (1.0f / S_A), e1[1] * (1.0f / S_A)), ab::cvtpk_s(e2[0] * (1.0f / S_A), e2[1] * (1.0f / S_A)), ab::cvtpk_s(e3[0] * (1.0f / S_A), e3[1] * (1.0f / S_A))};
                        xh[rt][k4] = __builtin_bit_cast(bf16x8, hb);
                        { const int rl = 32 * rt + r32, ch = F.wave * 16 + 2 * (4 * kq + k4) + hi; xl[rt][k4] = *(LAS const bf16x8*)(LO + rl * 2048 + ((ch ^ (rl & 15)) << 4)); } }
#pragma unroll
                for (int k4 = 0; k4 < 4; ++k4)
#pragma unroll
                    for (int rt = 0; rt < 2; ++rt) { const int ks = 4 * kq + k4;
                        acc[rt] = __builtin_amdgcn_mfma_f32_32x32x16_bf16(xh[rt][k4], wh[ks], acc[rt], 0, 0, 0);
                        acc[rt] = __builtin_amdgcn_mfma_f32_32x32x16_bf16(xh[rt][k4], wl[ks], acc[rt], 0, 0, 0);
                        acc[rt] = __builtin_amdgcn_mfma_f32_32x32x16_bf16(xl[rt][k4], wh[ks], acc[rt], 0, 0, 0); }
            }
            asm volatile("s_waitcnt lgkmcnt(0)" ::: "memory");
            __syncthreads();
#pragma unroll
            for (int rt = 0; rt < 2; ++rt)
#pragma unroll
                for (int r = 0; r < 16; ++r) part[(F.wave * 64 + 32 * rt + ab::crow(r, hi)) * 32 + r32] = acc[rt][r];
        }
        __syncthreads();
#pragma unroll
        for (int q = 0; q < 4; ++q) { const int idx = F.tid + 512 * q, row = idx >> 5, e = idx & 31; float s = a.in[13][e];
#pragma unroll
            for (int w = 0; w < 8; ++w) s += part[(w * 64 + row) * 32 + e];
            lg[row * 33 + e] = s; }
        __syncthreads();
        if (F.wave == 0) {
            float v0 = -INFINITY, v1 = -INFINITY, v2 = -INFINITY, v3 = -INFINITY; int i0 = 0, i1 = 0, i2 = 0, i3 = 0;
#pragma unroll
            for (int e = 0; e < 32; ++e) { const float g = lg[lane * 33 + e];
                if (g > v0) { v3 = v2; i3 = i2; v2 = v1; i2 = i1; v1 = v0; i1 = i0; v0 = g; i0 = e; }
                else if (g > v1) { v3 = v2; i3 = i2; v2 = v1; i2 = i1; v1 = g; i1 = e; }
                else if (g > v2) { v3 = v2; i3 = i2; v2 = g; i2 = e; }
                else if (g > v3) { v3 = g; i3 = e; } }
            const float e1 = __expf(v1 - v0), e2 = __expf(v2 - v0), e3 = __expf(v3 - v0); const float inv = 1.0f / (1.0f + e1 + e2 + e3);
            rsel[lane * 4 + 0] = i0; rsel[lane * 4 + 1] = i1; rsel[lane * 4 + 2] = i2; rsel[lane * 4 + 3] = i3;
            rgate[lane * 4 + 0] = inv; rgate[lane * 4 + 1] = e1 * inv; rgate[lane * 4 + 2] = e2 * inv; rgate[lane * 4 + 3] = e3 * inv;
            rrank[lane * 4 + 0] = (int)__hip_atomic_fetch_add(hist + i0, 1, __ATOMIC_RELAXED, __HIP_MEMORY_SCOPE_WORKGROUP);
            rrank[lane * 4 + 1] = (int)__hip_atomic_fetch_add(hist + i1, 1, __ATOMIC_RELAXED, __HIP_MEMORY_SCOPE_WORKGROUP);
            rrank[lane * 4 + 2] = (int)__hip_atomic_fetch_add(hist + i2, 1, __ATOMIC_RELAXED, __HIP_MEMORY_SCOPE_WORKGROUP);
            rrank[lane * 4 + 3] = (int)__hip_atomic_fetch_add(hist + i3, 1, __ATOMIC_RELAXED, __HIP_MEMORY_SCOPE_WORKGROUP);
        }
        __syncthreads();
        if (F.tid < 32) { const int hc = hist[F.tid]; ebase[F.tid] = hc > 0 ? (int)__hip_atomic_fetch_add((unsigned*)(F.ctl + CW_ECNT + F.tid), (unsigned)hc, __ATOMIC_RELAXED, __HIP_MEMORY_SCOPE_AGENT) : 0; }
        __syncthreads();
        if (F.tid < 256) { const int e = rsel[F.tid]; const size_t gi = (size_t)(c * CHR) * 4 + F.tid; const int loc = ebase[e] + rrank[F.tid]; EIDX[gi] = e; LOC[gi] = loc; GATE[gi] = rgate[F.tid];
            ((int*)(a.ws + WS_ELIST))[e * 16384 + loc] = c * CHR + (F.tid >> 2); }
        __syncthreads();
    }
}

__device__ __forceinline__ int moe_layout(Frame& F, LAS int* pstart, LAS int* tileE) {
    if (F.tid < 64) {
        const int e = F.tid, cn = e < NE ? (int)__hip_atomic_load(F.ctl + CW_ECNT + e, RLX_AGENT) : 0, nt = (cn + 255) >> 8;
        int inc = nt;
#pragma unroll
        for (int o = 1; o < 32; o <<= 1) { const int y = __shfl_up(inc, o); if (e >= o) inc += y; }
        const int t0 = inc - nt;
        if (e < NE) { pstart[64 + e] = cn; pstart[e] = t0 * 256; for (int i = 0; i < nt; ++i) tileE[t0 + i] = e; }
        if (e == NE - 1) { pstart[NE] = inc * 256; pstart[NE + 1] = inc; }
    }
    __syncthreads();
    return pstart[NE + 1];
}
__device__ __forceinline__ void phase12(const Args& a, Frame& F, bool have_layout) {
    const float* mod = (const float*)(a.ws + WS_MOD);
    const bf16* __restrict__ Y = (const bf16*)(a.ws + WS_Y); const int* __restrict__ EIDX = (const int*)(a.ws + WS_EIDX); const int* __restrict__ LOC = (const int*)(a.ws + WS_LOC); const float* __restrict__ GATE = (const float*)(a.ws + WS_GATE);
    LAS int* pstart = (LAS int*)(F.lds + X_OFF); LAS int* tileE = pstart + 128;
    if (!have_layout) (void)moe_layout(F, pstart, tileE);
    f32x4 GF[4], GA[4];
#pragma unroll
    for (int j = 0; j < 4; ++j) { const int c = 256 * j + 4 * F.lane; GF[j] = *(const f32x4*)(a.in[11] + c) * *(const f32x4*)(mod + 5120 + c);
        GA[j] = *(const f32x4*)(a.in[5] + c) * *(const f32x4*)(mod + 2048 + c); }
    const bf16* __restrict__ AO = (const bf16*)(a.ws + WS_AO); const float* __restrict__ xin = a.in[0]; const float* __restrict__ RS1 = (const float*)(a.ws + WS_RS1);
    const int gw = F.bid * NWAVES + F.wave, NGW = F.G * NWAVES;
    for (int tb = gw; tb < SEQ; tb += 16 * NGW) {
    int posL = 0; float gateL = 0.f;
    { const int tt = tb + (F.lane >> 2) * NGW; if (tt < SEQ) { const int ix = tt * 4 + (F.lane & 3); posL = pstart[EIDX[ix]] + LOC[ix]; gateL = GATE[ix] * (FP8M ? 1.0f / S_Y : 1.0f); } }
#pragma unroll 2
    for (int ti = 0; ti < 16; ++ti) {
        const int t = tb + ti * NGW; if (t >= SEQ) break;
        f32x4 y[4];
#pragma unroll
        for (int j = 0; j < 4; ++j) y[j] = (f32x4){0.f, 0.f, 0.f, 0.f};
#pragma unroll
        for (int k = 0; k < 4; ++k) { const int pos = __shfl(posL, ti * 4 + k); const float gk = __shfl(gateL, ti * 4 + k);
#pragma unroll
            for (int j = 0; j < 4; ++j) {
                if constexpr (FP8M) { const unsigned v = __builtin_nontemporal_load((const unsigned*)((const unsigned char*)Y + (size_t)pos * DM + 256 * j + 4 * F.lane));
                    const auto lo = __builtin_amdgcn_cvt_pk_f32_fp8((int)v, false), hi2 = __builtin_amdgcn_cvt_pk_f32_fp8((int)v, true);
                    y[j] += (f32x4){lo[0], lo[1], hi2[0], hi2[1]} * gk; }
                else { const u32x2 v = __builtin_nontemporal_load((const u32x2*)(Y + (size_t)pos * DM + 256 * j + 4 * F.lane));
                    y[j] += (f32x4){__uint_as_float(v.x << 16), __uint_as_float(v.x & 0xffff0000u), __uint_as_float(v.y << 16), __uint_as_float(v.y & 0xffff0000u)} * gk; } } }
        float ss = 0.f;
#pragma unroll
        for (int j = 0; j < 4; ++j) ss += (y[j][0] * y[j][0] + y[j][1] * y[j][1]) + (y[j][2] * y[j][2] + y[j][3] * y[j][3]);
        const float rs = 1.0f / sqrtf(wave_sum(ss) * (1.0f / DM) + RMS_EPS);
        float* __restrict__ orow = a.out + (size_t)t * DM + 4 * F.lane; const float r1 = RS1[t];
#pragma unroll
        for (int j = 0; j < 4; ++j) { const int cc = 256 * j + 4 * F.lane;
            const u32x2 av = __builtin_nontemporal_load((const u32x2*)(AO + (size_t)t * DM + cc)); const f32x4 xv = __builtin_nontemporal_load((const f32x4*)(xin + (size_t)t * DM + cc));
            const f32x4 ao = (f32x4){__uint_as_float(av.x << 16), __uint_as_float(av.x & 0xffff0000u), __uint_as_float(av.y << 16), __uint_as_float(av.y & 0xffff0000u)};
            const f32x4 x1 = xv + (ao * r1) * GA[j];
            __builtin_nontemporal_store(x1 + (y[j] * rs) * GF[j], (f32x4*)(orow + 256 * j)); }
    }
    }
}

constexpr int NPHASE = 13;
__global__ void __launch_bounds__(NWAVES * 64, 2) fwd_kernel(Args args) {
    extern __shared__ __attribute__((aligned(16))) unsigned char lds[];
    Frame F;
    F.lds = (LAS unsigned char*)lds;
    F.tid = threadIdx.x; F.lane = F.tid & 63; F.wave = __builtin_amdgcn_readfirstlane(F.tid >> 6);
    F.G = gridDim.x; F.bid = blockIdx.x;
    F.ctl = (gu32*)(args.ws + WS_CTL);
    volatile LAS unsigned* MISC = (volatile LAS unsigned*)(F.lds + MISC_OFF);
    if (F.tid < 64) MISC[F.tid] = 0u;
    __syncthreads();
    const int lo = args.ph_lo, hi = args.ph_hi;
    const bool multi = (hi - lo) > 1;
    XcdBarrier bar; bar.bar = (unsigned*)(F.ctl + CW_BAR); bar.x = 0; bar.st = nullptr;
    if (multi) bar = xcd_barrier_post((unsigned*)(F.ctl + CW_BAR), MISC + 8);
#define IN(k) (lo <= (k) && (k) < hi)
#define SEAM(k) do { if (IN(k) && IN((k) + 1)) xcd_barrier(bar); } while (0)
    const pg8::bf16_t* XNp = (const pg8::bf16_t*)(args.ws + WS_XN);

    if (IN(0)) { phase0(args, F); SEAM(0); }
    if (IN(1)) { phase1(args, F); SEAM(1); }
    if (IN(2)) {
        cum_chunks(args, F);
        pg8::Gemm g{XNp, (const pg8::bf16_t*)(args.ws + WS_WTIN), SEQ, PITCH, DM}; pg8::StaticOrder S; S.init(SEQ, PITCH, F.G, F.bid);
        pg8::EpiProj E{(pg8::bf16_t*)(args.ws + WS_PROJ), PITCH, C2, (float*)(F.ctl + CW_KMS), (unsigned*)(F.ctl + CW_KN2H), (unsigned*)(F.ctl + CW_QN2H)};
        if (side_gu(F.G)) { const unsigned m8 = __builtin_amdgcn_readfirstlane(MISC[8]), m9 = __builtin_amdgcn_readfirstlane(MISC[9]);
            pg8::gemm_phase<pg8::EpiProj, pg8::StaticOrder, PG8_ALIGN, true, pg8::SideCvt>(F.lds, g, S, E, side_make(args, F, 0, 24));
            if (F.tid == 0) { MISC[8] = m8; MISC[9] = m9; } }
        else pg8::gemm_phase<pg8::EpiProj, pg8::StaticOrder, PG8_ALIGN, PG8_SP2>(F.lds, g, S, E);
        SEAM(2);
    }
    if (IN(4)) { phase4(args, F); SEAM(4); }
    if (IN(5)) { phase5(args, F); SEAM(5); }
    if (IN(6)) { phase6(args, F, IN(5)); SEAM(6); }
    if (IN(7)) {
        pg8::Gemm g{(const pg8::bf16_t*)(args.ws + WS_MIX), (const pg8::bf16_t*)(args.ws + WS_WTOUT), SEQ, DM, DM}; pg8::StaticOrder S; S.init(SEQ, DM, F.G, F.bid);
        pg8::EpiBf16<0> E{(pg8::bf16_t*)(args.ws + WS_AO), DM, nullptr, 0, 0, 1.f};
        if (side_gu(F.G)) { const unsigned m8 = __builtin_amdgcn_readfirstlane(MISC[8]), m9 = __builtin_amdgcn_readfirstlane(MISC[9]);
            pg8::gemm_phase<pg8::EpiBf16<0>, pg8::StaticOrder, PG8_ALIGN, true, pg8::SideCvt>(F.lds, g, S, E, side_make(args, F, 24, 8));
            if (F.tid == 0) { MISC[8] = m8; MISC[9] = m9; } }
        else pg8::gemm_phase<pg8::EpiBf16<0>, pg8::StaticOrder, PG8_ALIGN, PG8_SP2>(F.lds, g, S, E);
        SEAM(7);
    }
    if (IN(8)) { phase8(args, F); SEAM(8); }
    if (IN(10)) {
        LAS int* pstart = (LAS int*)(F.lds + X_OFF); LAS int* tileE = pstart + 128; LAS int* xrow = (LAS int*)(F.lds + X_OFF + 2048);
        const int T = __builtin_amdgcn_readfirstlane(moe_layout(F, pstart, tileE));
        const int groups = (F.G % 8 == 0) ? 8 : 1, per = F.G / groups;
        pg8::MoeSched<false> S{tileE, T, 8, groups == 8 ? (F.bid & 7) : 0, groups == 8 ? (F.bid >> 3) : F.bid, per, groups, 13};
        { pg8::Unit u; const int* EL = (const int*)(args.ws + WS_ELIST);
          const int tl = F.tid & 255, par = F.tid >> 8; int rv[7];
#pragma unroll
          for (int k = 0; k < 7; ++k) { const int i = 2 * k + par; rv[k] = 0;
              if (S.next(i, u)) { const int lt = u.pm - (pstart[u.e] >> 8), nvalid = pstart[64 + u.e] - lt * 256; if (tl < nvalid) rv[k] = EL[u.e * 16384 + lt * 256 + tl]; } }
#pragma unroll
          for (int k = 0; k < 7; ++k) { const int i = 2 * k + par; if (i < 13) xrow[i * 256 + tl] = rv[k]; }
          __syncthreads(); }
        pg8::Gemm2 g{FP8M ? (const unsigned char*)(args.ws + WS_XN8) : (const unsigned char*)(args.ws + WS_XN), (const unsigned char*)(args.ws + WS_WTGU), DM, xrow};
        pg8::EpiSwiglu E{args.ws + WS_ACT, args.in[15], 1.0f / (S_A * S_W)};
        pg8::gemm_phase2<pg8::EpiSwiglu, pg8::MoeSched<false>, PG8_ALIGN, FP8M, true>(F.lds, g, S, E);
        SEAM(10);
    }
    if (IN(11)) {
        LAS int* pstart = (LAS int*)(F.lds + X_OFF); LAS int* tileE = pstart + 128;
        const int T = __builtin_amdgcn_readfirstlane(IN(10) ? pstart[NE + 1] : moe_layout(F, pstart, tileE));
        const int groups = (F.G % 8 == 0) ? 8 : 1, per = F.G / groups;
        pg8::MoeSched<true> S{tileE, T, 4, groups == 8 ? (F.bid & 7) : 0, groups == 8 ? (F.bid >> 3) : F.bid, per, groups, 1 << 30};
        pg8::Gemm2 g{(const unsigned char*)(args.ws + WS_ACT), (const unsigned char*)(args.ws + WS_WTDN), DM, nullptr};
        pg8::EpiDown E{args.ws + WS_Y, args.in[17], 1.0f / (S_ACT * S_W)};
        pg8::gemm_phase2<pg8::EpiDown, pg8::MoeSched<true>, PG8_ALIGN, FP8M, false>(F.lds, g, S, E);
        SEAM(11);
    }
    if (IN(12)) { phase12(args, F, IN(10) || IN(11)); }
#undef IN
#undef SEAM
}

#ifndef MK_PER_PHASE
#define MK_PER_PHASE 0
#endif
extern "C" void kernel_launch(void* const* d_in, const int* in_sizes, int n_in, void* d_out, int out_size, void* d_ws, size_t ws_size, hipStream_t stream) {
    static int grid = 0;
    if (grid == 0) {
        if (n_in != 18 || in_sizes[0] != SEQ * DM || out_size != SEQ * DM || ws_size < WS_END) { fprintf(stderr, "kernel_launch: unexpected shapes (n_in %d, in0 %d, out %d, ws %zu); nothing launched\n", n_in, n_in > 0 ? in_sizes[0] : -1, out_size, ws_size); grid = -1; return; }
        int dev = 0, cus = 0, per_cu = 0;
        if (hipGetDevice(&dev) != hipSuccess || hipDeviceGetAttribute(&cus, hipDeviceAttributeMultiprocessorCount, dev) != hipSuccess) { grid = -1; return; }
        if (hipFuncSetAttribute((const void*)fwd_kernel, hipFuncAttributeMaxDynamicSharedMemorySize, LDS_BYTES) != hipSuccess) { fprintf(stderr, "kernel_launch: hipFuncSetAttribute failed\n"); grid = -1; return; }
        if (hipOccupancyMaxActiveBlocksPerMultiprocessor(&per_cu, (const void*)fwd_kernel, NWAVES * 64, LDS_BYTES) != hipSuccess || per_cu < 1) { fprintf(stderr, "kernel_launch: occupancy query reports %d workgroups per CU\n", per_cu); }
        (void)hipGetLastError();
        grid = cus;
    }
    if (grid < 0) return;
    if (hipMemsetAsync((char*)d_ws + WS_CTL, 0, CTL_ZERO_BYTES, stream) != hipSuccess) return;
    Args a{};
    for (int i = 0; i < 18; ++i) a.in[i] = (const float*)d_in[i];
    a.out = (float*)d_out; a.ws = (unsigned char*)d_ws;
#if MK_PER_PHASE
    for (int p = 0; p < NPHASE; ++p) { a.ph_lo = p; a.ph_hi = p + 1; hipLaunchKernelGGL(fwd_kernel, dim3(grid), dim3(NWAVES * 64), LDS_BYTES, stream, a); }
#else
    a.ph_lo = 0; a.ph_hi = NPHASE; hipLaunchKernelGGL(fwd_kernel, dim3(grid), dim3(NWAVES * 64), LDS_BYTES, stream, a);
#endif
}
```

```cpp
#include <hip/hip_runtime.h>
#include <hip/hip_bf16.h>
#include <cstdio>
#include <cstdint>
#include <cmath>
namespace pg8 {
#define PG8_LAS __attribute__((address_space(3)))
typedef unsigned short bf16_t;
typedef short bf16x8 __attribute__((ext_vector_type(8)));
typedef float f32x4 __attribute__((ext_vector_type(4)));
typedef unsigned u32x4 __attribute__((ext_vector_type(4)));
constexpr int BM = 256, BK = 64, HALF = 128, HTB = HALF * BK * 2  , STAGE_BYTES = 8 * HTB, NXCD = 8, WGM = 8;

__host__ __device__ __forceinline__ int lds_byte(int r, int c) { const int st = (r >> 4) * 2 + (c >> 5), rr = r & 15, cc = c & 31, ob = rr * 64 + cc * 2; return st * 1024 + (ob ^ (((ob >> 9) & 1) << 5)); }
__host__ __device__ __forceinline__ void stage_rc(int b, int& R, int& C) { const int st = b / 1024, sb = b % 1024, swz = sb ^ (((sb >> 9) & 1) << 5); R = (st >> 1) * 16 + swz / 64; C = (st & 1) * 32 + (swz % 64) / 2; }
__host__ __device__ __forceinline__ int perm32(int rho) { const int n = rho >> 4, i = rho & 15; return 8 * (i >> 2) + 4 * n + (i & 3); }

struct Unit { int pm, pn, pb, e, nh; };
struct Gemm { const bf16_t* A; const bf16_t* Bt; int M, N, K; };

struct StaticOrder {
    int nM, nN, nwg, G, c;
    __host__ __device__ void init(int M, int N, int G_, int c_) { nM = M / BM; nN = N / BM; nwg = nM * nN; G = G_; c = c_; }
    __host__ __device__ bool next(int i, Unit& u) const {
        const long L = (long)i * G + c; if (L >= nwg) return false;
        int wgid = (int)L; { const int q = nwg / NXCD, r = nwg % NXCD, xcd = wgid % NXCD, off = wgid / NXCD; wgid = (xcd < r ? xcd * (q + 1) : r * (q + 1) + (xcd - r) * q) + off; }
        const int nig = WGM * nN, gid = wgid / nig, fm = gid * WGM, gsz = (nM - fm) < WGM ? (nM - fm) : WGM;
        u.pm = fm + ((wgid % nig) % gsz); u.pn = (wgid % nig) / gsz; u.pb = u.pn; u.e = 0; u.nh = 0; return true;
    }
    __device__ __forceinline__ void a_ready(const Unit&) const {}
    __device__ __forceinline__ void done(const Unit&) const {}
};

__device__ __forceinline__ unsigned cvt_pk_bf16(float lo, float hi) { unsigned r; asm volatile("v_cvt_pk_bf16_f32 %0, %1, %2" : "=v"(r) : "v"(lo), "v"(hi)); return r; }
typedef float f32x2 __attribute__((ext_vector_type(2)));
__device__ __forceinline__ f32x2 gelu_pk(f32x2 v) {
    const f32x2 av = __builtin_elementwise_abs(v), d = av * 0.2316418882f + 1.0f;
    f32x2 t; t.x = __builtin_amdgcn_rcpf(d.x); t.y = __builtin_amdgcn_rcpf(d.y);
    f32x2 q = t * 0.5307027145f + (-0.7265760135f); q = q * t + 0.7107068705f; q = q * t + (-0.142248368f); q = q * t + 0.127414796f; q = q * t;
    const f32x2 s = (v * v) * (-0.72134752044f);
    f32x2 e; e.x = __builtin_amdgcn_exp2f(s.x); e.y = __builtin_amdgcn_exp2f(s.y);
    const f32x2 m = v * (q * e), r = v - m;
    f32x2 o; o.x = v.x < 0.f ? m.x : r.x; o.y = v.y < 0.f ? m.y : r.y; return o;
}

template <int ACT  > struct EpiBf16 {
    static constexpr bool PERM = true, AFTER_DRAIN = false; static_assert(ACT == 0 || ACT == 1, "EpiBf16: ACT is 0 (none) or 1 (gelu_pk)");
    bf16_t* O; int ldc; const float* bias; int split_cols; size_t split_stride; float scale0;
    __device__ __forceinline__ void operator()(const f32x4 (&acc)[2][2][4][2], const Unit& u, int wr, int wc, int fr, int fq) const {
        const int row0 = u.pm * BM + wr * 64 + fr; int colt = u.pn * BM; bf16_t* base = O;
        float sc = 1.f; if (split_cols) { const int t = colt / split_cols; base += (size_t)t * split_stride; colt -= t * split_cols; if (t == 0) sc = scale0; }
        const int col0 = colt + wc * 32 + 8 * fq, bcol0 = u.pn * BM + wc * 32 + 8 * fq;
        f32x4 bv[2][2];
#pragma unroll
        for (int bj = 0; bj < 2; ++bj)
#pragma unroll
            for (int n = 0; n < 2; ++n) bv[bj][n] = bias ? *(const f32x4*)(bias + bcol0 + bj * HALF + 4 * n) : (f32x4){0.f, 0.f, 0.f, 0.f};
#pragma unroll
        for (int ai = 0; ai < 2; ++ai)
#pragma unroll
            for (int m = 0; m < 4; ++m) { bf16_t* rowp = base + (size_t)(row0 + ai * HALF + m * 16) * ldc + col0;
#pragma unroll
                for (int bj = 0; bj < 2; ++bj) { f32x4 v0 = acc[ai][bj][m][0] + bv[bj][0], v1 = acc[ai][bj][m][1] + bv[bj][1];
                    if (ACT == 1) { f32x2 a = gelu_pk((f32x2){v0[0], v0[1]}), b = gelu_pk((f32x2){v0[2], v0[3]}), c = gelu_pk((f32x2){v1[0], v1[1]}), d = gelu_pk((f32x2){v1[2], v1[3]});
                        v0 = (f32x4){a.x, a.y, b.x, b.y}; v1 = (f32x4){c.x, c.y, d.x, d.y}; }
                    v0 = v0 * sc; v1 = v1 * sc; u32x4 w; w.x = cvt_pk_bf16(v0[0], v0[1]); w.y = cvt_pk_bf16(v0[2], v0[3]); w.z = cvt_pk_bf16(v1[0], v1[1]); w.w = cvt_pk_bf16(v1[2], v1[3]);
                    *(u32x4*)(rowp + bj * HALF) = w; } }
    }
};
struct NoSide { static constexpr bool ACTIVE = false; };
template <class Epi, class Sched, bool ALIGN_EPI = false, bool SP2 = false, class Side = NoSide>
__device__ __forceinline__ void gemm_phase(PG8_LAS unsigned char* lds, const Gemm g, const Sched& S, const Epi& E, Side sd = Side()) {
    const int tid = threadIdx.x, wid = __builtin_amdgcn_readfirstlane(tid >> 6), lane = tid & 63, wr = wid >> 2, wc = wid & 3, fr = lane & 15, fq = lane >> 4;
    const int K = g.K, nt = K / BK;
    unsigned voffA[2], voffB[2];
#pragma unroll
    for (int i = 0; i < 2; ++i) { int R, C; stage_rc(tid * 16 + i * 8192, R, C); const int Rb = Epi::PERM ? ((R & ~31) + perm32(R & 31)) : R;
        voffA[i] = (unsigned)(R * K + C) * 2u; voffB[i] = (unsigned)(Rb * K + C) * 2u; }
    const size_t kstep = (size_t)(BK * 2);
    const size_t hstep = (size_t)HALF * K * 2;
    const size_t tstep = 2 * hstep;
    const unsigned ldsw = (unsigned)wid * 1024u;
    const int aoff = lds_byte(wr * 64 + fr, fq * 8), boff = lds_byte(wc * 32 + fr, fq * 8);
#define PG8_SA(b, h) (((b) * 2 + (h)) * HTB)
#define PG8_SB(b, h) ((4 + (b) * 2 + (h)) * HTB)
#define PG8_STAGE(bufoff, gbase, voff) do { _Pragma("unroll") for (int _i = 0; _i < 2; ++_i) \
        __builtin_amdgcn_global_load_lds((const unsigned*)((const char*)(gbase) + (voff)[_i]), (PG8_LAS unsigned*)(lds + (bufoff) + ldsw + _i * 8192), 16, 0, 0); } while (0)
#define PG8_LDA(dst, b, h) do { _Pragma("unroll") for (int m = 0; m < 4; ++m) _Pragma("unroll") for (int k = 0; k < 2; ++k) dst[m][k] = *(const PG8_LAS bf16x8*)(lds + PG8_SA(b, h) + aoff + m * 2048 + k * 1024); } while (0)
#define PG8_LDB(dst, b, h) do { _Pragma("unroll") for (int n = 0; n < 2; ++n) _Pragma("unroll") for (int k = 0; k < 2; ++k) dst[n][k] = *(const PG8_LAS bf16x8*)(lds + PG8_SB(b, h) + boff + n * 2048 + k * 1024); } while (0)
#define PG8_MMA(ai, bj, At, Bt) do { __builtin_amdgcn_s_setprio(1); _Pragma("unroll") for (int m = 0; m < 4; ++m) _Pragma("unroll") for (int n = 0; n < 2; ++n) _Pragma("unroll") for (int k = 0; k < 2; ++k) \
        acc[ai][bj][m][n] = __builtin_amdgcn_mfma_f32_16x16x32_bf16(Bt[n][k], At[m][k], acc[ai][bj][m][n], 0, 0, 0); __builtin_amdgcn_s_setprio(0); } while (0)
#define PG8_WAIT_V(n) asm volatile("s_waitcnt vmcnt(" #n ")" ::: "memory")
#define PG8_WAIT_L(n) asm volatile("s_waitcnt lgkmcnt(" #n ")" ::: "memory")
#define PG8_BAR __builtin_amdgcn_s_barrier()
#define PG8_SCHED __builtin_amdgcn_sched_barrier(0)
    Unit cur, nxt; int ui = 0;
    if (!S.next(0, cur)) return;
    f32x4 acc[2][2][4][2];
#pragma unroll
    for (int a = 0; a < 2; ++a)
#pragma unroll
        for (int b = 0; b < 2; ++b)
#pragma unroll
            for (int m = 0; m < 4; ++m)
#pragma unroll
                for (int n = 0; n < 2; ++n) acc[a][b][m][n] = (f32x4){0.f, 0.f, 0.f, 0.f};
    bf16x8 At[4][2], B0[2][2], B1[2][2];
    const char* cA = (const char*)g.A + (size_t)cur.pm * tstep; const char* cB = (const char*)g.Bt + (size_t)cur.pb * tstep;
    S.a_ready(cur);
    bool sfull = false, infl = false; float sv[16];
    if constexpr (Side::ACTIVE) { static_assert(SP2, "side stream: SP2 loop only"); if (sd.left > 0) { sd.issue(lds); sfull = true; } }
    if constexpr (SP2) {
        PG8_STAGE(PG8_SB(0, 0), cB, voffB); PG8_STAGE(PG8_SB(0, 1), cB + hstep, voffB); PG8_STAGE(PG8_SA(0, 0), cA, voffA); PG8_STAGE(PG8_SA(0, 1), cA + hstep, voffA);
        if (wr == 1) PG8_BAR;
        PG8_WAIT_V(2); PG8_BAR;
        PG8_STAGE(PG8_SB(1, 0), cB + kstep, voffB); PG8_STAGE(PG8_SA(1, 0), cA + kstep, voffA); PG8_STAGE(PG8_SB(1, 1), cB + hstep + kstep, voffB);
        PG8_WAIT_V(6); PG8_BAR;
    } else {
        PG8_STAGE(PG8_SB(0, 0), cB, voffB); PG8_STAGE(PG8_SA(0, 0), cA, voffA); PG8_STAGE(PG8_SB(0, 1), cB + hstep, voffB); PG8_STAGE(PG8_SA(0, 1), cA + hstep, voffA);
        if (wr == 1) PG8_BAR;
        PG8_WAIT_V(4); PG8_BAR;
        PG8_STAGE(PG8_SB(1, 0), cB + kstep, voffB); PG8_STAGE(PG8_SA(1, 0), cA + kstep, voffA); PG8_STAGE(PG8_SB(1, 1), cB + hstep + kstep, voffB);
        PG8_WAIT_V(6); PG8_BAR;
    }
    for (;;) {
        const bool has_next = S.next(ui + 1, nxt);
        const char* nA = has_next ? (const char*)g.A + (size_t)nxt.pm * tstep : cA; const char* nB = has_next ? (const char*)g.Bt + (size_t)nxt.pb * tstep : cB;
        for (int t = 0; t < nt; t += 2) {
            const bool last = (t == nt - 2);
            const char* a1 = cA + (size_t)(t + 1) * kstep;
            const char* a2 = last ? nA : cA + (size_t)(t + 2) * kstep; const char* b2 = last ? nB : cB + (size_t)(t + 2) * kstep;
            const char* a3 = a2 + kstep; const char* b3 = b2 + kstep;
            if (last && has_next) S.a_ready(nxt);
            if constexpr (SP2) {
            PG8_LDB(B0, 0, 0); PG8_LDB(B1, 0, 1); PG8_SCHED; PG8_LDA(At, 0, 0); PG8_STAGE(PG8_SA(1, 1), a1 + hstep, voffA);
            if (Side::ACTIVE && infl) PG8_WAIT_V(13); else PG8_WAIT_V(8);
            PG8_WAIT_L(0); PG8_BAR; PG8_MMA(0, 0, At, B0); PG8_MMA(0, 1, At, B1); PG8_BAR; PG8_SCHED;
            PG8_LDA(At, 0, 1); PG8_STAGE(PG8_SB(0, 0), b2, voffB); PG8_STAGE(PG8_SB(0, 1), b2 + hstep, voffB); PG8_STAGE(PG8_SA(0, 0), a2, voffA);
            if (Side::ACTIVE && infl) PG8_WAIT_V(13); else PG8_WAIT_V(8);
            PG8_WAIT_L(0); PG8_BAR; PG8_MMA(1, 0, At, B0); PG8_MMA(1, 1, At, B1); PG8_BAR; PG8_SCHED;
            PG8_LDB(B0, 1, 0); PG8_LDB(B1, 1, 1); PG8_SCHED; PG8_LDA(At, 1, 0); PG8_STAGE(PG8_SA(0, 1), a2 + hstep, voffA);
            PG8_WAIT_V(8); PG8_WAIT_L(0); PG8_BAR; PG8_MMA(0, 0, At, B0); PG8_MMA(0, 1, At, B1); PG8_BAR; PG8_SCHED;
            PG8_LDA(At, 1, 1);
            if constexpr (Side::ACTIVE) { if (sfull) sd.read(lds, sv, lane); }
            PG8_STAGE(PG8_SB(1, 0), b3, voffB); PG8_STAGE(PG8_SB(1, 1), b3 + hstep, voffB); PG8_STAGE(PG8_SA(1, 0), a3, voffA);
            PG8_WAIT_V(8); PG8_WAIT_L(0);
            const bool sst = sfull;
            if constexpr (Side::ACTIVE) { infl = false; if (sfull) { if (sd.left > 0) { sd.issue(lds); infl = true; } else sfull = false; } }
            PG8_BAR; PG8_MMA(1, 0, At, B0); PG8_MMA(1, 1, At, B1);
            if constexpr (Side::ACTIVE) { if (sst) sd.store(sv); }
            PG8_BAR; PG8_SCHED;
            } else {
            PG8_LDB(B0, 0, 0); PG8_SCHED; PG8_LDA(At, 0, 0); PG8_STAGE(PG8_SA(1, 1), a1 + hstep, voffA);
            PG8_WAIT_L(8); PG8_BAR; PG8_WAIT_L(0); PG8_MMA(0, 0, At, B0); PG8_BAR; PG8_SCHED;
            PG8_LDB(B1, 0, 1); PG8_STAGE(PG8_SB(0, 0), b2, voffB);
            PG8_BAR; PG8_WAIT_L(0); PG8_MMA(0, 1, At, B1); PG8_BAR;
            PG8_LDA(At, 0, 1); PG8_STAGE(PG8_SA(0, 0), a2, voffA);
            PG8_BAR; PG8_WAIT_L(0); PG8_MMA(1, 0, At, B0); PG8_BAR; PG8_SCHED;
            PG8_STAGE(PG8_SB(0, 1), b2 + hstep, voffB);
            PG8_WAIT_V(6); PG8_BAR; PG8_MMA(1, 1, At, B1); PG8_BAR;
            PG8_LDB(B0, 1, 0); PG8_SCHED; PG8_LDA(At, 1, 0); PG8_STAGE(PG8_SA(0, 1), a2 + hstep, voffA);
            PG8_WAIT_L(8); PG8_BAR; PG8_WAIT_L(0); PG8_MMA(0, 0, At, B0); PG8_BAR; PG8_SCHED;
            PG8_LDB(B1, 1, 1); PG8_STAGE(PG8_SB(1, 0), b3, voffB);
            PG8_BAR; PG8_WAIT_L(0); PG8_MMA(0, 1, At, B1); PG8_BAR;
            PG8_LDA(At, 1, 1); PG8_STAGE(PG8_SA(1, 0), a3, voffA);
            PG8_BAR; PG8_WAIT_L(0); PG8_MMA(1, 0, At, B0); PG8_BAR; PG8_SCHED;
            PG8_STAGE(PG8_SB(1, 1), b3 + hstep, voffB);
            PG8_WAIT_V(6); PG8_BAR; PG8_MMA(1, 1, At, B1); PG8_BAR;
            }
        }
        if constexpr (ALIGN_EPI) { if (wr == 0) PG8_BAR; }
        if constexpr (!Epi::AFTER_DRAIN) { E(acc, cur, wr, wc, fr, fq); S.done(cur); }
        if (!has_next) break;
#pragma unroll
        for (int a = 0; a < 2; ++a)
#pragma unroll
            for (int b = 0; b < 2; ++b)
#pragma unroll
                for (int m = 0; m < 4; ++m)
#pragma unroll
                    for (int n = 0; n < 2; ++n) acc[a][b][m][n] = (f32x4){0.f, 0.f, 0.f, 0.f};
        cur = nxt; cA = nA; cB = nB; ++ui;
        if constexpr (ALIGN_EPI) { if (wr == 1) PG8_BAR; }
    }
    PG8_WAIT_V(0);
    if constexpr (!ALIGN_EPI) { if (wr == 0) PG8_BAR; }
    PG8_BAR;
    if constexpr (Epi::AFTER_DRAIN) { E.fused(acc, cur, wr, wc, fr, fq, lds, wid, lane); S.done(cur); }
#undef PG8_SA
#undef PG8_SB
#undef PG8_STAGE
#undef PG8_LDA
#undef PG8_LDB
#undef PG8_MMA
#undef PG8_WAIT_V
#undef PG8_WAIT_L
#undef PG8_BAR
#undef PG8_SCHED
}
}
#ifndef PG8_SP2
#define PG8_SP2 true
#endif
#ifndef PG8_ALIGN
#define PG8_ALIGN true
#endif
namespace pg8 {
typedef int i32x4v __attribute__((ext_vector_type(4)));
typedef int i32x8v __attribute__((ext_vector_type(8)));
__device__ __forceinline__ const char* uptr(const char* p) { const unsigned long long v = (unsigned long long)p; const unsigned lo = __builtin_amdgcn_readfirstlane((unsigned)v), hi = __builtin_amdgcn_readfirstlane((unsigned)(v >> 32)); return (const char*)(((unsigned long long)hi << 32) | lo); }
struct Gemm2 { const unsigned char* A; const unsigned char* Bt; int K; const PG8_LAS int* xrow; };
template <class Epi, class Sched, bool ALIGN_EPI, bool FP8, bool GATHER>
__device__ __forceinline__ void gemm_phase2(PG8_LAS unsigned char* lds, const Gemm2 g, const Sched& S, const Epi& E) {
    const int tid = threadIdx.x, wid = __builtin_amdgcn_readfirstlane(tid >> 6), lane = tid & 63, wr = wid >> 2, wc = wid & 3, fr = lane & 15, fq = lane >> 4;
    constexpr int ESZ = FP8 ? 1 : 2, BKE = FP8 ? 128 : 64;
    const int K = g.K, nt = K / BKE;
    unsigned voffA[2], voffB[2], voffC[2][2], voffN[2][2];
#pragma unroll
    for (int i = 0; i < 2; ++i) { int R, C; stage_rc(tid * 16 + i * 8192, R, C); const int Rb = Epi::PERM ? ((R & ~31) + perm32(R & 31)) : R;
        voffA[i] = (unsigned)(R * K * ESZ + C * 2); voffB[i] = (unsigned)(Rb * K * ESZ + C * 2); }
    const size_t kstep = 128;
    const size_t hstep = (size_t)HALF * K * ESZ;
    const size_t tstep = 2 * hstep;
    const unsigned ldsw = (unsigned)wid * 1024u;
    const int aoff = lds_byte(wr * 64 + fr, fq * 8), boff = lds_byte(wc * 32 + fr, fq * 8);
#define PG8_SA(b, h) (((b) * 2 + (h)) * HTB)
#define PG8_SB(b, h) ((4 + (b) * 2 + (h)) * HTB)
#define PG8_STAGE(bufoff, gbase, voff) do { unsigned long long gb_ = (unsigned long long)(gbase); asm volatile("" : "+s"(gb_));   \
        _Pragma("unroll") for (int _i = 0; _i < 2; ++_i) \
        __builtin_amdgcn_global_load_lds((const unsigned*)((const char*)gb_ + (voff)[_i]), (PG8_LAS unsigned*)(lds + (bufoff) + ldsw + _i * 8192), 16, 0, 0); } while (0)
#define PG8_STA(bufoff, h, kofs, nx) do { if constexpr (GATHER) { unsigned long long ga_ = (unsigned long long)((const char*)g.A + (kofs)); asm volatile("" : "+s"(ga_)); _Pragma("unroll") for (int _i = 0; _i < 2; ++_i) \
        __builtin_amdgcn_global_load_lds((const unsigned*)((const char*)ga_ + ((nx) ? voffN[h][_i] : voffC[h][_i])), (PG8_LAS unsigned*)(lds + (bufoff) + ldsw + _i * 8192), 16, 0, 0); } \
        else { PG8_STAGE(bufoff, ((nx) ? nA : cA) + (h) * hstep + (kofs), voffA); } } while (0)
#define PG8_LDA(dst, b, h) do { _Pragma("unroll") for (int m = 0; m < 4; ++m) { dst[m].lo = *(const PG8_LAS i32x4v*)(lds + PG8_SA(b, h) + aoff + m * 2048); dst[m].hi = *(const PG8_LAS i32x4v*)(lds + PG8_SA(b, h) + aoff + m * 2048 + 1024); } } while (0)
#define PG8_LDB(dst, b, h) do { _Pragma("unroll") for (int n = 0; n < 2; ++n) { dst[n].lo = *(const PG8_LAS i32x4v*)(lds + PG8_SB(b, h) + boff + n * 2048); dst[n].hi = *(const PG8_LAS i32x4v*)(lds + PG8_SB(b, h) + boff + n * 2048 + 1024); } } while (0)
#define PG8_MMA(ai, bj, At, Bt) do { __builtin_amdgcn_s_setprio(1); _Pragma("unroll") for (int m = 0; m < 4; ++m) _Pragma("unroll") for (int n = 0; n < 2; ++n) { \
        if constexpr (FP8) { asm volatile("v_mfma_f32_16x16x128_f8f6f4 %0, %1, %2, %0" : "+v"(acc[ai][bj][m][n]) : "v"(Bt[n]), "v"(At[m]));   } \
        else { acc[ai][bj][m][n] = __builtin_amdgcn_mfma_f32_16x16x32_bf16(__builtin_bit_cast(bf16x8, Bt[n].lo), __builtin_bit_cast(bf16x8, At[m].lo), acc[ai][bj][m][n], 0, 0, 0); \
               acc[ai][bj][m][n] = __builtin_amdgcn_mfma_f32_16x16x32_bf16(__builtin_bit_cast(bf16x8, Bt[n].hi), __builtin_bit_cast(bf16x8, At[m].hi), acc[ai][bj][m][n], 0, 0, 0); } } \
        __builtin_amdgcn_s_setprio(0); } while (0)
#define PG8_WAIT_V(n) asm volatile("s_waitcnt vmcnt(" #n ")" ::: "memory")
#define PG8_WAIT_L(n) asm volatile("s_waitcnt lgkmcnt(" #n ")" ::: "memory")
#define PG8_BAR __builtin_amdgcn_s_barrier()
#define PG8_SCHED __builtin_amdgcn_sched_barrier(0)
#define PG8_GOFF(dst, q) do { int tl_ = (int)threadIdx.x; asm volatile("" : "+v"(tl_));   \
        _Pragma("unroll") for (int i_ = 0; i_ < 2; ++i_) { int R_, C_; stage_rc(tl_ * 16 + i_ * 8192, R_, C_); \
        _Pragma("unroll") for (int h_ = 0; h_ < 2; ++h_) dst[h_][i_] = (unsigned)(g.xrow[(q) * 256 + h_ * HALF + R_] * K * ESZ + C_ * 2); } } while (0)
    Unit cur, nxt; int ui = 0;
    if (!S.next(0, cur)) return;
    f32x4 acc[2][2][4][2];
#pragma unroll
    for (int a = 0; a < 2; ++a)
#pragma unroll
        for (int b = 0; b < 2; ++b)
#pragma unroll
            for (int m = 0; m < 4; ++m)
#pragma unroll
                for (int n = 0; n < 2; ++n) acc[a][b][m][n] = (f32x4){0.f, 0.f, 0.f, 0.f};
    i32x8v At[4], B0[2], B1[2];
    const char* cA = uptr(GATHER ? (const char*)g.A : (const char*)g.A + (size_t)cur.pm * tstep + (Sched::HALFM && cur.nh == 2 ? hstep : 0)); const char* cB = uptr((const char*)g.Bt + (size_t)cur.pb * tstep);
    const char* nA = cA;
    if constexpr (GATHER) { PG8_GOFF(voffC, 0);
#pragma unroll
        for (int h_ = 0; h_ < 2; ++h_)
#pragma unroll
            for (int i_ = 0; i_ < 2; ++i_) voffN[h_][i_] = voffC[h_][i_]; }
    S.a_ready(cur);
    PG8_STAGE(PG8_SB(0, 0), cB, voffB); PG8_STAGE(PG8_SB(0, 1), cB + hstep, voffB); PG8_STA(PG8_SA(0, 0), 0, 0, false); PG8_STA(PG8_SA(0, 1), 1, 0, false);
    if (wr == 1) PG8_BAR;
    PG8_WAIT_V(2); PG8_BAR;
    PG8_STAGE(PG8_SB(1, 0), cB + kstep, voffB); PG8_STA(PG8_SA(1, 0), 0, kstep, false); PG8_STAGE(PG8_SB(1, 1), cB + hstep + kstep, voffB);
    PG8_WAIT_V(6); PG8_BAR;
    for (;;) {
        const bool has_next = S.next(ui + 1, nxt);
        nA = uptr((has_next && !GATHER) ? (const char*)g.A + (size_t)nxt.pm * tstep + (Sched::HALFM && nxt.nh == 2 ? hstep : 0) : cA); const char* nB = uptr(has_next ? (const char*)g.Bt + (size_t)nxt.pb * tstep : cB);
        if constexpr (GATHER) { if (has_next) { PG8_GOFF(voffN, ui + 1); } }
#pragma unroll 1
        for (int t = 0; t < nt; t += 2) {
            const bool last = (t == nt - 2);
            const size_t k1 = (size_t)(t + 1) * kstep, k2 = last ? 0 : (size_t)(t + 2) * kstep, k3 = k2 + kstep;
            const char* b2 = last ? nB : cB + (size_t)(t + 2) * kstep; const char* b3 = b2 + kstep;
            if (last && has_next) S.a_ready(nxt);
            if (last) E.prefetch(cur, wid, lane);
            PG8_LDB(B0, 0, 0); PG8_LDB(B1, 0, 1); PG8_SCHED; PG8_LDA(At, 0, 0); PG8_STA(PG8_SA(1, 1), 1, k1, false);
            PG8_WAIT_V(8); PG8_WAIT_L(0); PG8_BAR; PG8_MMA(0, 0, At, B0); PG8_MMA(0, 1, At, B1); PG8_BAR; PG8_SCHED;
            if (!(Sched::HALFM && cur.nh)) PG8_LDA(At, 0, 1);
            PG8_STAGE(PG8_SB(0, 0), b2, voffB); PG8_STAGE(PG8_SB(0, 1), b2 + hstep, voffB); PG8_STA(PG8_SA(0, 0), 0, k2, last);
            PG8_WAIT_V(8); PG8_WAIT_L(0); PG8_BAR; if (!(Sched::HALFM && cur.nh)) { PG8_MMA(1, 0, At, B0); PG8_MMA(1, 1, At, B1); } PG8_BAR; PG8_SCHED;
            PG8_LDB(B0, 1, 0); PG8_LDB(B1, 1, 1); PG8_SCHED; PG8_LDA(At, 1, 0); PG8_STA(PG8_SA(0, 1), 1, k2, last);
            PG8_WAIT_V(8); PG8_WAIT_L(0); PG8_BAR; PG8_MMA(0, 0, At, B0); PG8_MMA(0, 1, At, B1); PG8_BAR; PG8_SCHED;
            if (!(Sched::HALFM && cur.nh)) PG8_LDA(At, 1, 1);
            PG8_STAGE(PG8_SB(1, 0), b3, voffB); PG8_STAGE(PG8_SB(1, 1), b3 + hstep, voffB); PG8_STA(PG8_SA(1, 0), 0, k3, last);
            PG8_WAIT_V(8); PG8_WAIT_L(0); PG8_BAR; if (!(Sched::HALFM && cur.nh)) { PG8_MMA(1, 0, At, B0); PG8_MMA(1, 1, At, B1); } PG8_BAR; PG8_SCHED;
        }
        if constexpr (ALIGN_EPI) { if (wr == 0) PG8_BAR; }
        if constexpr (FP8) { asm volatile("s_nop 15\n\ts_nop 7" ::: "memory"); __builtin_amdgcn_sched_barrier(0); }
        E(acc, cur, wr, wc, fr, fq); S.done(cur);
        if (!has_next) break;
#pragma unroll
        for (int a = 0; a < 2; ++a)
#pragma unroll
            for (int b = 0; b < 2; ++b)
#pragma unroll
                for (int m = 0; m < 4; ++m)
#pragma unroll
                    for (int n = 0; n < 2; ++n) acc[a][b][m][n] = (f32x4){0.f, 0.f, 0.f, 0.f};
        cur = nxt; cA = nA; cB = nB; ++ui;
        if constexpr (GATHER) {
#pragma unroll
            for (int h_ = 0; h_ < 2; ++h_)
#pragma unroll
                for (int i_ = 0; i_ < 2; ++i_) voffC[h_][i_] = voffN[h_][i_]; }
        if constexpr (ALIGN_EPI) { if (wr == 1) PG8_BAR; }
    }
    PG8_WAIT_V(0);
    if constexpr (!ALIGN_EPI) { if (wr == 0) PG8_BAR; }
    PG8_BAR;
#undef PG8_SA
#undef PG8_SB
#undef PG8_STAGE
#undef PG8_STA
#undef PG8_LDA
#undef PG8_LDB
#undef PG8_MMA
#undef PG8_WAIT_V
#undef PG8_WAIT_L
#undef PG8_BAR
#undef PG8_SCHED
#undef PG8_GOFF
}
}
namespace pg8 {
#ifndef USE_FP8
#define USE_FP8 1
#endif
constexpr bool FP8M_EPI = USE_FP8 != 0; constexpr float SACT_EPI = FP8M_EPI ? 4.f : 1.f, SY_EPI = 32.f;
typedef unsigned u32x2v __attribute__((ext_vector_type(2)));
__device__ __forceinline__ unsigned f8pk4e(float a, float b, float c, float d) {
    a = fminf(fmaxf(a, -448.f), 448.f); b = fminf(fmaxf(b, -448.f), 448.f); c = fminf(fmaxf(c, -448.f), 448.f); d = fminf(fmaxf(d, -448.f), 448.f);
    unsigned w = 0u; w = (unsigned)__builtin_amdgcn_cvt_pk_fp8_f32(a, b, (int)w, false); w = (unsigned)__builtin_amdgcn_cvt_pk_fp8_f32(c, d, (int)w, true); return w;
}
struct EpiProj {
    static constexpr bool PERM = true, AFTER_DRAIN = false;
    bf16_t* O; int ldc; float qscale;
    float* kms;
    unsigned* kn2h;
    unsigned* qn2h;
    __device__ __forceinline__ void operator()(const f32x4 (&acc)[2][2][4][2], const Unit& u, int wr, int wc, int fr, int fq) const {
        const int row0 = u.pm * BM + wr * 64 + fr, col0 = u.pn * BM + wc * 32 + 8 * fq;
        const float sc = (u.pn < 2 || u.pn == 6 || u.pn == 7) ? qscale : 1.f;
#pragma unroll
        for (int ai = 0; ai < 2; ++ai)
#pragma unroll
            for (int m = 0; m < 4; ++m) { bf16_t* rowp = O + (size_t)(row0 + ai * HALF + m * 16) * ldc + col0;
#pragma unroll
                for (int bj = 0; bj < 2; ++bj) { const f32x4 v0 = acc[ai][bj][m][0] * sc, v1 = acc[ai][bj][m][1] * sc;
                    u32x4 w; w.x = cvt_pk_bf16(v0[0], v0[1]); w.y = cvt_pk_bf16(v0[2], v0[3]); w.z = cvt_pk_bf16(v1[0], v1[1]); w.w = cvt_pk_bf16(v1[2], v1[3]);
                    *(u32x4*)(rowp + bj * HALF) = w; } }
        asm volatile("" : "+v"(fr), "+v"(fq));
        if (u.pn < 4) {
#pragma unroll
            for (int bj = 0; bj < 2; ++bj) { float mx = 0.f;
#pragma unroll
                for (int ai = 0; ai < 2; ++ai)
#pragma unroll
                    for (int m = 0; m < 4; ++m) { const f32x4 v0 = acc[ai][bj][m][0], v1 = acc[ai][bj][m][1];
                        float q = (v0[0] * v0[0] + v0[1] * v0[1]) + (v0[2] * v0[2] + v0[3] * v0[3]) + (v1[0] * v1[0] + v1[1] * v1[1]) + (v1[2] * v1[2] + v1[3] * v1[3]);
                        q += __shfl_xor(q, 16); q += __shfl_xor(q, 32); mx = fmaxf(mx, q); __builtin_amdgcn_sched_barrier(0); }
                mx = fmaxf(mx, __shfl_xor(mx, 1)); mx = fmaxf(mx, __shfl_xor(mx, 2)); mx = fmaxf(mx, __shfl_xor(mx, 4)); mx = fmaxf(mx, __shfl_xor(mx, 8));
                if (fr == 0 && fq == 0) { const int head = (u.pn & 1) * 4 + 2 * bj + (wc >> 1);
                    unsigned* ap = (u.pn < 2) ? qn2h + (u.pm * 8 + head) * 2 + (wc & 1) : kn2h + head * 2 + (wc & 1);
                    asm volatile("global_atomic_umax %0, %1, off" :: "v"(ap), "v"(__float_as_uint(mx * sc * sc)) : "memory"); } }
        } else if (u.pn == 8 || u.pn == 9) {
#pragma unroll
            for (int bj = 0; bj < 2; ++bj)
#pragma unroll
                for (int n = 0; n < 2; ++n)
#pragma unroll
                    for (int i = 0; i < 4; ++i) { float cs = 0.f;
#pragma unroll
                        for (int ai = 0; ai < 2; ++ai)
#pragma unroll
                            for (int m = 0; m < 4; ++m) cs += acc[ai][bj][m][n][i];
                        cs += __shfl_xor(cs, 1); cs += __shfl_xor(cs, 2); cs += __shfl_xor(cs, 4); cs += __shfl_xor(cs, 8); __builtin_amdgcn_sched_barrier(0);
                        if (fr == 0) { const int head = (u.pn - 8) * 4 + 2 * bj + (wc >> 1), d = 32 * (wc & 1) + 8 * fq + 4 * n + i; float* ap = kms + ((size_t)head * 64 + u.pm) * 64 + d;
                            asm volatile("global_atomic_add_f32 %0, %1, off" :: "v"(ap), "v"(cs) : "memory"); } }
        }
    }
};
struct EpiSwiglu {
    static constexpr bool PERM = true, AFTER_DRAIN = false;
    unsigned char* O; const float* bias; float sc; PG8_LAS unsigned char* bslot;
    __device__ __forceinline__ void prefetch(const Unit& u, int wid, int lane) const {
        const float* src = bias + (size_t)u.e * 2048 + u.pn * HALF + (wid & 3) * 32 + (lane < 32 ? lane : 1024 - 32 + lane);
        __builtin_amdgcn_global_load_lds((const unsigned*)src, (PG8_LAS unsigned*)(bslot + wid * 256), 4, 0, 0); }
    __device__ __forceinline__ void operator()(const f32x4 (&acc)[2][2][4][2], const Unit& u, int wr, int wc, int fr, int fq) const {
        asm volatile("" : "+v"(fr), "+v"(fq));
        const int row0 = u.pm * BM + wr * 64 + fr, oc0 = u.pn * HALF + wc * 32 + 8 * fq;
        const PG8_LAS float* bg = (const PG8_LAS float*)(bslot + (wr * 4 + wc) * 256) + 8 * fq;
        const f32x4 g0 = *(const PG8_LAS f32x4*)(bg), g1 = *(const PG8_LAS f32x4*)(bg + 4), l0 = *(const PG8_LAS f32x4*)(bg + 32), l1 = *(const PG8_LAS f32x4*)(bg + 36);
#pragma unroll
        for (int ai = 0; ai < 2; ++ai) { if (u.nh != 0 && ai == 1) break;
#pragma unroll
            for (int m = 0; m < 4; ++m) { const size_t eo = (size_t)(row0 + (u.nh == 2 ? HALF : 0) + ai * HALF + m * 16) * 1024 + oc0;
                typedef float f32x2v __attribute__((ext_vector_type(2)));
                const f32x2v sc2 = {sc, sc};
                float r[8];
#pragma unroll
                for (int pq = 0; pq < 4; ++pq) { const int hq = pq >> 1, e0 = 2 * (pq & 1);
                    const f32x4 ag = acc[ai][0][m][hq], al = acc[ai][1][m][hq], bg = hq ? g1 : g0, bl = hq ? l1 : l0;
                    f32x2v xg = (f32x2v){ag[e0], ag[e0 + 1]} * sc2 + (f32x2v){bg[e0], bg[e0 + 1]}, xl = (f32x2v){al[e0], al[e0 + 1]} * sc2 + (f32x2v){bl[e0], bl[e0 + 1]};
                    xg = (f32x2v){fminf(xg[0], 7.0f), fminf(xg[1], 7.0f)}; xl = (f32x2v){__builtin_amdgcn_fmed3f(xl[0], -7.0f, 7.0f), __builtin_amdgcn_fmed3f(xl[1], -7.0f, 7.0f)};
                    const f32x2v tt = xg * (f32x2v){-1.702f * 1.4426950408889634f, -1.702f * 1.4426950408889634f};
                    const f32x2v den = (f32x2v){__builtin_amdgcn_exp2f(tt[0]), __builtin_amdgcn_exp2f(tt[1])} + (f32x2v){1.0f, 1.0f};
                    const f32x2v sg = (f32x2v){__builtin_amdgcn_rcpf(den[0]), __builtin_amdgcn_rcpf(den[1])};
                    const f32x2v lin = FP8M_EPI ? xl * (f32x2v){SACT_EPI, SACT_EPI} + (f32x2v){SACT_EPI, SACT_EPI} : xl + (f32x2v){1.0f, 1.0f};
                    const f32x2v rr = (xg * sg) * lin;
                    r[2 * pq] = rr[0]; r[2 * pq + 1] = rr[1]; }
                if constexpr (FP8M_EPI) { u32x2v w; unsigned w0 = 0u, w1 = 0u;
                    w0 = (unsigned)__builtin_amdgcn_cvt_pk_fp8_f32(r[0], r[1], (int)w0, false); w0 = (unsigned)__builtin_amdgcn_cvt_pk_fp8_f32(r[2], r[3], (int)w0, true);
                    w1 = (unsigned)__builtin_amdgcn_cvt_pk_fp8_f32(r[4], r[5], (int)w1, false); w1 = (unsigned)__builtin_amdgcn_cvt_pk_fp8_f32(r[6], r[7], (int)w1, true);
                    w.x = w0; w.y = w1; *(u32x2v*)(O + eo) = w; }
                else { u32x4 w; w.x = cvt_pk_bf16(r[0], r[1]); w.y = cvt_pk_bf16(r[2], r[3]); w.z = cvt_pk_bf16(r[4], r[5]); w.w = cvt_pk_bf16(r[6], r[7]); *(u32x4*)(O + eo * 2) = w; } } }
    }
};
struct EpiDown {
    static constexpr bool PERM = true, AFTER_DRAIN = false;
    unsigned char* O; const float* bias; float sc; PG8_LAS unsigned char* bslot;
    __device__ __forceinline__ void prefetch(const Unit& u, int wid, int lane) const {
        const float* src = bias + (size_t)u.e * 1024 + u.pn * BM + (wid & 3) * 32 + (lane < 32 ? lane : HALF - 32 + lane);
        __builtin_amdgcn_global_load_lds((const unsigned*)src, (PG8_LAS unsigned*)(bslot + wid * 256), 4, 0, 0); }
    __device__ __forceinline__ void operator()(const f32x4 (&acc)[2][2][4][2], const Unit& u, int wr, int wc, int fr, int fq) const {
        asm volatile("" : "+v"(fr), "+v"(fq));
        const int row0 = u.pm * BM + wr * 64 + fr, col0 = u.pn * BM + wc * 32 + 8 * fq;
        const PG8_LAS float* bp = (const PG8_LAS float*)(bslot + (wr * 4 + wc) * 256) + 8 * fq;
        f32x4 bv[2][2];
#pragma unroll
        for (int bj = 0; bj < 2; ++bj)
#pragma unroll
            for (int n = 0; n < 2; ++n) bv[bj][n] = *(const PG8_LAS f32x4*)(bp + bj * 32 + 4 * n) * (FP8M_EPI ? SY_EPI : 1.0f);
        const float scy = FP8M_EPI ? sc * SY_EPI : sc;
#pragma unroll
        for (int ai = 0; ai < 2; ++ai) { if (u.nh != 0 && ai == 1) break;
#pragma unroll
            for (int m = 0; m < 4; ++m) { const int row = row0 + (u.nh == 2 ? HALF : 0) + ai * HALF + m * 16; const size_t eo = (size_t)row * 1024 + col0;
#pragma unroll
                for (int bj = 0; bj < 2; ++bj) { typedef float f32x2v __attribute__((ext_vector_type(2))); const f32x2v sy2 = {scy, scy};
                    const f32x4 q0 = acc[ai][bj][m][0], q1 = acc[ai][bj][m][1], c0 = bv[bj][0], c1 = bv[bj][1];
                    const f32x2v w00 = (f32x2v){q0[0], q0[1]} * sy2 + (f32x2v){c0[0], c0[1]}, w01 = (f32x2v){q0[2], q0[3]} * sy2 + (f32x2v){c0[2], c0[3]};
                    const f32x2v w10 = (f32x2v){q1[0], q1[1]} * sy2 + (f32x2v){c1[0], c1[1]}, w11 = (f32x2v){q1[2], q1[3]} * sy2 + (f32x2v){c1[2], c1[3]};
                    const f32x4 v0 = {w00[0], w00[1], w01[0], w01[1]}, v1 = {w10[0], w10[1], w11[0], w11[1]};
                    if constexpr (FP8M_EPI) { u32x2v w; w.x = f8pk4e(v0[0], v0[1], v0[2], v0[3]); w.y = f8pk4e(v1[0], v1[1], v1[2], v1[3]); *(u32x2v*)(O + eo + bj * HALF) = w; }
                    else { u32x4 w; w.x = cvt_pk_bf16(v0[0], v0[1]); w.y = cvt_pk_bf16(v0[2], v0[3]); w.z = cvt_pk_bf16(v1[0], v1[1]); w.w = cvt_pk_bf16(v1[2], v1[3]); *(u32x4*)(O + (eo + bj * HALF) * 2) = w; } } } }
    }
};
template <bool HM>
struct MoeSched {
    static constexpr bool HALFM = HM;
    const PG8_LAS int* tileE; int T, NC, x, r, per, groups, maxu;
    __device__ __forceinline__ bool next(int i, Unit& u) const {
        const int lo = x * T / groups, hi = (x + 1) * T / groups, U = (hi - lo) * NC; int ul = i * per + r, nh = 0;
        if constexpr (HM) { const int full = U / per, L = U - full * per;
            if (i == full && L > 0 && 2 * L <= per) { if (r >= 2 * L) return false; ul = full * per + (r >> 1); nh = 1 + (r & 1); } }
        if (ul >= U || i >= maxu) return false;
        const int tile = lo + ul / NC, pn = ul % NC, e = __builtin_amdgcn_readfirstlane(tileE[tile]);
        u.pm = tile; u.pn = pn; u.pb = e * NC + pn; u.e = e; u.nh = nh; return true;
    }
    __device__ __forceinline__ void a_ready(const Unit&) const {}
    __device__ __forceinline__ void done(const Unit&) const {}
};
struct SideCvt {
    static constexpr bool ACTIVE = true;
    const char* sbase; unsigned char* dbase; unsigned voffs, voffd, lrd; int slot, left, ji, js; float sw;
    __device__ __forceinline__ void issue(PG8_LAS unsigned char* lds) {
        unsigned long long b = (unsigned long long)(sbase + (size_t)(ji & 15) * (64 * 8192) + (size_t)(ji >> 4) * 512); asm volatile("" : "+s"(b));
#pragma unroll
        for (int p = 0; p < 4; ++p) __builtin_amdgcn_global_load_lds((const unsigned*)((const char*)b + (size_t)p * 8192 + voffs), (PG8_LAS unsigned*)(lds + slot + p * 1024), 16, 0, 2);
        ++ji; --left;
    }
    __device__ __forceinline__ void read(PG8_LAS unsigned char* lds, float (&v)[16], int) const {
#pragma unroll
        for (int j = 0; j < 16; ++j) v[j] = *(const PG8_LAS float*)(lds + slot + (j & 3) * 1024 + (j >> 2) * 256 + lrd);
    }
    __device__ __forceinline__ void store(const float (&v)[16]) {
        u32x4 o; o.x = f8pk4e(v[0] * sw, v[1] * sw, v[2] * sw, v[3] * sw); o.y = f8pk4e(v[4] * sw, v[5] * sw, v[6] * sw, v[7] * sw);
        o.z = f8pk4e(v[8] * sw, v[9] * sw, v[10] * sw, v[11] * sw); o.w = f8pk4e(v[12] * sw, v[13] * sw, v[14] * sw, v[15] * sw);
        *(u32x4*)(dbase + (size_t)(js >> 4) * (256 * 1024) + (size_t)(js & 15) * 64 + voffd) = o; ++js;
    }
};
}
namespace attn_body {
using bf16=__hip_bfloat16;
using bf16x8=__attribute__((ext_vector_type(8)))short;
using s16x4=__attribute__((ext_vector_type(4)))short;
using f32x16=__attribute__((ext_vector_type(16)))float;
using u32x4=__attribute__((ext_vector_type(4)))unsigned;
__device__ __forceinline__ int crow(int r,int hi){return (r&3)+8*(r>>2)+4*hi;}
#define SBAR() __builtin_amdgcn_sched_barrier(0)
__device__ __forceinline__ void cmask(f32x16&p0,f32x16&p1,int jb,int qrel,int hi){
  const float NEG=-INFINITY; int kb=64*jb+4*hi;
  #pragma unroll
  for(int r=0;r<16;++r){int kv=kb+(r&3)+8*(r>>2); if(kv>qrel)p0[r]=NEG; if(kv+32>qrel)p1[r]=NEG;}
}
__device__ __forceinline__ void glds16(const void*gsrc,unsigned lds_dst){unsigned keep;
  asm volatile("s_mov_b32 %0, m0\n\ts_mov_b32 m0, %2\n\ts_nop 0\n\tglobal_load_lds_dwordx4 %1, off\n\ts_mov_b32 m0, %0":"=&s"(keep):"v"(gsrc),"s"(lds_dst):"memory");}
__device__ __forceinline__ float max3f(float a,float b,float c){float r;asm("v_max3_f32 %0, %1, %2, %3":"=v"(r):"v"(a),"v"(b),"v"(c));return r;}
__device__ __forceinline__ float max2f(float a,float b){float r;asm("v_max_f32_e32 %0, %1, %2":"=v"(r):"v"(a),"v"(b));return r;}
__device__ __forceinline__ float fadd_s(float a,float b){float r;asm("v_add_f32_e32 %0, %1, %2":"=v"(r):"v"(a),"v"(b));return r;}
__device__ __forceinline__ float fsub_s(float a,float b){float r;asm("v_sub_f32_e32 %0, %1, %2":"=v"(r):"v"(a),"v"(b));return r;}
typedef float f32x2_t __attribute__((ext_vector_type(2))); typedef __bf16 bf16x2_t __attribute__((ext_vector_type(2)));
__device__ __forceinline__ unsigned cvtpk_s(float lo,float hi){f32x2_t v={lo,hi};bf16x2_t b=__builtin_convertvector(v,bf16x2_t);return __builtin_bit_cast(unsigned,b);}
__device__ __forceinline__ float rowmax(const f32x16&p0,const f32x16&p1){
  float a=max3f(p0[0],p0[1],p1[0]),b=max3f(p0[2],p0[3],p1[1]);a=max3f(a,p1[2],p1[3]);
  #pragma unroll
  for(int r=4;r<16;r+=4){a=max3f(a,p0[r],p0[r+1]);b=max3f(b,p0[r+2],p0[r+3]);a=max3f(a,p1[r],p1[r+1]);b=max3f(b,p1[r+2],p1[r+3]);}
  const float m=max2f(a,b);
  auto rr=__builtin_amdgcn_permlane32_swap(__float_as_uint(m),__float_as_uint(m),false,false);
  return max2f(__uint_as_float(rr[0]),__uint_as_float(rr[1]));
}
__device__ __forceinline__ void pv(f32x16*o,int vb,bf16x8 pa0,bf16x8 pa1,bf16x8 pa2,bf16x8 pa3){
  #pragma unroll
  for(int d0=0;d0<2;++d0){s16x4 lo[4],hi[4];
    #pragma unroll
    for(int ks=0;ks<4;++ks){
      asm volatile("ds_read_b64_tr_b16 %0,%1 offset:%c2":"=&v"(lo[ks]):"v"(vb),"i"(d0*4096+ks*1024):"memory");
      asm volatile("ds_read_b64_tr_b16 %0,%1 offset:%c2":"=&v"(hi[ks]):"v"(vb),"i"(d0*4096+ks*1024+512):"memory");}
    asm volatile("s_waitcnt lgkmcnt(0)":::"memory");SBAR();
    #define PK(k) (bf16x8){lo[k][0],lo[k][1],lo[k][2],lo[k][3],hi[k][0],hi[k][1],hi[k][2],hi[k][3]}
    o[d0]=__builtin_amdgcn_mfma_f32_32x32x16_bf16(pa0,PK(0),o[d0],0,0,0);
    o[d0]=__builtin_amdgcn_mfma_f32_32x32x16_bf16(pa1,PK(1),o[d0],0,0,0);
    o[d0]=__builtin_amdgcn_mfma_f32_32x32x16_bf16(pa2,PK(2),o[d0],0,0,0);
    o[d0]=__builtin_amdgcn_mfma_f32_32x32x16_bf16(pa3,PK(3),o[d0],0,0,0);
    #undef PK
  }
}
#undef SBAR
}
#define GAS __attribute__((address_space(1)))
#define LAS __attribute__((address_space(3)))
typedef unsigned short bf16;
typedef unsigned v4u __attribute__((ext_vector_type(4)));
typedef float f32x4 __attribute__((ext_vector_type(4)));
typedef short bf16x8 __attribute__((ext_vector_type(8)));
typedef GAS unsigned gu32;
typedef GAS unsigned long long gu64;
#define RLX_AGENT __ATOMIC_RELAXED, __HIP_MEMORY_SCOPE_AGENT
#define LDS_WAIT() asm volatile("s_waitcnt lgkmcnt(0)" ::: "memory")
#define VM_WAIT() asm volatile("s_waitcnt vmcnt(0)" ::: "memory")
__device__ __forceinline__ unsigned long long rt() { return __builtin_amdgcn_s_memrealtime(); }
__device__ __forceinline__ unsigned f2bf(float f) { unsigned u = __builtin_bit_cast(unsigned, f); return (u + 0x7fffu + ((u >> 16) & 1u)) >> 16; }
__device__ __forceinline__ unsigned pk2(float lo, float hi) { return f2bf(lo) | (f2bf(hi) << 16); }

#define XB_TMO      128
#define XB_XCNT(j)  (256  + 64 * (j))
#define XB_XSUB(j)  (1280 + 64 * (j))
#define XB_XGEN(j)  (2304 + 64 * (j))
#define XB_TOP      3328
#define XB_TOPGEN   3392
#define XCD_BAR_WORDS 3456
#define XB_SPIN_CAP (1u << 18)

__device__ __forceinline__ unsigned xb_ld(unsigned* p)              { return __hip_atomic_load(p, __ATOMIC_RELAXED, __HIP_MEMORY_SCOPE_AGENT); }
__device__ __forceinline__ unsigned xb_add(unsigned* p, unsigned v) { return __hip_atomic_fetch_add(p, v, __ATOMIC_RELAXED, __HIP_MEMORY_SCOPE_AGENT); }
__device__ __forceinline__ unsigned xb_xcc_id() { return (unsigned)__builtin_amdgcn_s_getreg((3 << 11) | 20) & 0xFu; }
#define XB_SPIN(cond, bar) do { unsigned _sp = 0; while (cond) { __builtin_amdgcn_s_sleep(1); \
    if ((++_sp & 255u) == 0u) { if (xb_ld(&(bar)[XB_TMO])) break; if (_sp > XB_SPIN_CAP) { atomicAdd(&(bar)[XB_TMO], 1u); break; } } } } while (0)

struct XcdBarrier {
    unsigned* bar; unsigned x;
    volatile LAS unsigned* st;
};

__device__ __forceinline__ XcdBarrier xcd_barrier_post(unsigned* bar, volatile LAS unsigned* st) {
    XcdBarrier b; b.bar = bar; b.x = xb_xcc_id(); b.st = st;
    if (threadIdx.x == 0) (void)xb_add(&bar[XB_XCNT(b.x)], 1u);
    return b;
}
__device__ __forceinline__ void xcd_barrier_complete(unsigned* bar, unsigned x, unsigned& nloc, unsigned& nx) {
    const unsigned G = gridDim.x * gridDim.y * gridDim.z;
    unsigned sum, cnt, mine, sp = 0u;
    for (;;) {
        sum = 0u; cnt = 0u; mine = 0u;
#pragma unroll
        for (unsigned j = 0; j < 16; ++j) { const unsigned c = xb_ld(&bar[XB_XCNT(j)]); sum += c; cnt += (c > 0u) ? 1u : 0u; mine = (j == x) ? c : mine; }
        if (sum == G) break;
        __builtin_amdgcn_s_sleep(1);
        if ((++sp & 255u) == 0u) { if (xb_ld(&bar[XB_TMO])) break; if (sp > XB_SPIN_CAP) { atomicAdd(&bar[XB_TMO], 1u); break; } }
    }
    nloc = mine > 0u ? mine : 1u; nx = cnt > 0u ? cnt : 1u;
}

__device__ __forceinline__ void xcd_barrier(const XcdBarrier& b) {
    asm volatile("s_waitcnt vmcnt(0)" ::: "memory");
    __syncthreads();
    if (threadIdx.x == 0) {
        unsigned* bar = b.bar;
        __builtin_amdgcn_s_waitcnt(0);
        unsigned nloc = b.st[0], nx = b.st[1];
        if (nloc == 0u) { xcd_barrier_complete(bar, b.x, nloc, nx); b.st[0] = nloc; b.st[1] = nx; }
        const unsigned old = xb_add(&bar[XB_XSUB(b.x)], 1u);
        const unsigned gen = old / nloc;
        if (old + 1u == (gen + 1u) * nloc) {
            __builtin_amdgcn_fence(__ATOMIC_RELEASE, "agent");
            asm volatile("s_waitcnt vmcnt(0)" ::: "memory");
            const unsigned og = xb_add(&bar[XB_TOP], 1u);
            const unsigned tg = og / nx;
            if (og + 1u == (tg + 1u) * nx) xb_add(&bar[XB_TOPGEN], 1u);
            else XB_SPIN(xb_ld(&bar[XB_TOPGEN]) == tg, bar);
            __builtin_amdgcn_fence(__ATOMIC_ACQUIRE, "agent");
            xb_add(&bar[XB_XGEN(b.x)], 1u);
            asm volatile("s_waitcnt vmcnt(0)" ::: "memory");
        } else {
            XB_SPIN(xb_ld(&bar[XB_XGEN(b.x)]) == gen, bar);
            __builtin_amdgcn_fence(__ATOMIC_ACQUIRE, "agent");
            asm volatile("s_waitcnt vmcnt(0)" ::: "memory");
        }
    }
    __syncthreads();
}
#ifndef USE_FP8
#define USE_FP8 1
#endif
constexpr bool FP8M = USE_FP8 != 0;
constexpr int MESZ = FP8M ? 1 : 2;
constexpr float S_Y = 32.f;
constexpr float S_W = FP8M ? 256.f : 1.f, S_A = FP8M ? 8.f : 1.f, S_ACT = FP8M ? 4.f : 1.f;
namespace ab = attn_body;
using ab::f32x16;
typedef unsigned u32x4 __attribute__((ext_vector_type(4)));
typedef unsigned u32x2 __attribute__((ext_vector_type(2)));

constexpr int NWAVES = 8;
constexpr int SEQ = 16384, DM = 1024, NH = 8, HD = 64, PITCH = 3072, INW = 3080;
constexpr int NE = 32, TOPK = 4;
constexpr int NCHUNK = 256, CHR = 64;
constexpr int NMB = 64;
constexpr int RMAX = 65536 + 32 * 256, TMAX = RMAX / 256;
constexpr float RMS_EPS = 1e-6f, LOG2E = 1.4426950408889634f, C2 = 0.125f * 1.4426950408889634f;
constexpr int LCAP = 256 * 2016;
constexpr int OFF_QA = 0, OFF_KA = 512, OFF_VA = 1024, OFF_QB = 1536, OFF_KB = 2048, OFF_VB = 2560;

constexpr size_t MiB = 1u << 20;
constexpr size_t WS_CTL = 0, CTL_ZERO_BYTES = 393216;
constexpr size_t WS_MOD = 1 * MiB, WS_TOT = WS_MOD + 65536, WS_RS1 = WS_MOD + 131072;
constexpr size_t WS_LOGF = 2 * MiB, WS_CUM = 2 * MiB + 524288;
constexpr size_t WS_WTOUT = 4 * MiB, WS_WTIN = 6 * MiB;
constexpr size_t WS_WRT = 3 * MiB + 524288;
constexpr size_t WS_WFT = 3 * MiB + 786432;
constexpr size_t WS_XNLO = 914 * MiB;
constexpr size_t WS_EIDX = 12 * MiB, WS_GATE = WS_EIDX + 262144, WS_LOC = WS_GATE + 262144;
constexpr size_t WS_ELIST = 946 * MiB;
constexpr size_t WS_XN8 = 948 * MiB;
constexpr size_t WS_PM = 14 * MiB, WS_PL = 16 * MiB, WS_MLIST = 18 * MiB;
constexpr size_t WS_XN = 34 * MiB, WS_PROJ = 66 * MiB, WS_MIX = 162 * MiB, WS_AO = 194 * MiB, WS_PO = 226 * MiB;
constexpr size_t WS_WTGU = 290 * MiB, WS_WTDN = 418 * MiB, WS_ACT = 626 * MiB, WS_Y = 770 * MiB, WS_END = 964 * MiB;
static_assert((size_t)NH * LCAP * 4 <= 16 * MiB && (size_t)RMAX * 1024 * 2 == 144 * MiB, "d_ws map");
constexpr int CW_BAR = 4096;
constexpr int CW_GCNT = 32768;
constexpr int CW_ECNT = 40960;
constexpr int CW_KN2H = 49152;
constexpr int CW_QN2H = 50176;
constexpr int CW_GATE = 60064;
constexpr int CW_KMS = 65536;
static_assert((CW_KMS + 8 * 64 * 64) * 4 <= (int)CTL_ZERO_BYTES, "CTL words inside the memset");

constexpr int RING_BYTES = 131072;
constexpr int MISC_OFF = RING_BYTES;
constexpr int X_OFF = RING_BYTES + 256;
constexpr int LDS_BYTES = 163840;
constexpr int A_K = 0, A_V = 32768, A_LUT = 65536, A_WS = 81920, A_OST = 84224, A_PFX = 116992;

struct Args { const float* in[18]; float* out; unsigned char* ws; int ph_lo, ph_hi; };
struct Frame { LAS unsigned char* lds; gu32* ctl; int tid, lane, wave, G, bid; };

#ifndef SIDE_GU
#define SIDE_GU 1
#endif
__device__ __forceinline__ bool side_gu(int G) { return SIDE_GU && FP8M && G == 256; }
__device__ __forceinline__ pg8::SideCvt side_make(const Args& a, const Frame& F, int j0, int n);
__device__ __forceinline__ int vchunk(int c, int G) { return (G == 256) ? ((c & 7) * 32 + (c >> 3)) : c; }
__device__ __forceinline__ float bf2f(unsigned short b) { return __uint_as_float((unsigned)b << 16); }
__device__ __forceinline__ float wave_sum(float v) {
#pragma unroll
    for (int o = 1; o < 64; o <<= 1) v += __shfl_xor(v, o);
    return v;
}
__device__ __forceinline__ float wave_max(float v) {
#pragma unroll
    for (int o = 1; o < 64; o <<= 1) v = fmaxf(v, __shfl_xor(v, o));
    return v;
}
__device__ __forceinline__ double wave_sum_d(double v) {
#pragma unroll
    for (int o = 1; o < 64; o <<= 1) { const int lo = __shfl_xor(__double2loint(v), o), hi = __shfl_xor(__double2hiint(v), o); v += __hiloint2double(hi, lo); }
    return v;
}
__device__ __forceinline__ unsigned f8pk4(float a, float b, float c, float d) {
    a = fminf(fmaxf(a, -448.f), 448.f); b = fminf(fmaxf(b, -448.f), 448.f); c = fminf(fmaxf(c, -448.f), 448.f); d = fminf(fmaxf(d, -448.f), 448.f);
    unsigned w = 0u; w = (unsigned)__builtin_amdgcn_cvt_pk_fp8_f32(a, b, (int)w, false); w = (unsigned)__builtin_amdgcn_cvt_pk_fp8_f32(c, d, (int)w, true); return w;
}
__device__ __forceinline__ unsigned lds_addr(LAS const void* p) { return (unsigned)(uintptr_t)p; }
__device__ __forceinline__ int t5_bucket(int d) {
    if (d < 16) return d;
    int b = 16;
    b += (d >= 19); b += (d >= 21); b += (d >= 24); b += (d >= 27); b += (d >= 31); b += (d >= 35); b += (d >= 40); b += (d >= 46);
    b += (d >= 52); b += (d >= 59); b += (d >= 67); b += (d >= 77); b += (d >= 87); b += (d >= 99); b += (d >= 113);
    return b;
}

struct CvtItem { const float* src; unsigned char* dst; int ldn; int esz; };
constexpr int CVT_NITEMS = 96 + 32 + 2048 + 1024;
__device__ __forceinline__ CvtItem cvt_decode(const Args& a, int it, int w, int ngu) {
    CvtItem c;
    if (it < 96) { const int ng = (it >> 4) * 8 + w, kg = it & 15; c.src = a.in[6] + (size_t)(kg * 64) * INW + ng * 64; c.ldn = INW; c.dst = a.ws + WS_WTIN + ((size_t)(ng * 64) * 1024 + kg * 64) * 2; c.esz = 2; return c; }
    it -= 96;
    if (it < 32) { const int ng = (it >> 4) * 8 + w, kg = it & 15; c.src = a.in[9] + (size_t)(kg * 64) * 1024 + ng * 64; c.ldn = 1024; c.dst = a.ws + WS_WTOUT + ((size_t)(ng * 64) * 1024 + kg * 64) * 2; c.esz = 2; return c; }
    it -= 32;
    if (it < ngu) { const int e = it >> 6, rem = it & 63, ng = (rem >> 4) * 8 + w, kg = rem & 15, c0 = ng * 64;
        const int drow = (c0 < 1024) ? (c0 >> 7) * 256 + (c0 & 127) : ((c0 - 1024) >> 7) * 256 + 128 + ((c0 - 1024) & 127);
        c.src = a.in[14] + (size_t)e * 1024 * 2048 + (size_t)(kg * 64) * 2048 + c0; c.ldn = 2048; c.dst = a.ws + WS_WTGU + ((size_t)(e * 2048 + drow) * 1024 + kg * 64) * MESZ; c.esz = MESZ; return c; }
    it -= ngu;
    { const int e = it >> 5, rem = it & 31, ng = (rem >> 4) * 8 + w, kg = rem & 15;
      c.src = a.in[16] + (size_t)e * 1024 * 1024 + (size_t)(kg * 64) * 1024 + ng * 64; c.ldn = 1024; c.dst = a.ws + WS_WTDN + ((size_t)(e * 1024 + ng * 64) * 1024 + kg * 64) * MESZ; c.esz = MESZ; return c; }
}
__device__ __forceinline__ pg8::SideCvt side_make(const Args& a, const Frame& F, int j0, int n) {
    const int c = F.bid, e = c >> 3, c0 = ((2 * c) & 15) * 128 + F.wave * 16;
    const int drow = (c0 < 1024) ? (c0 >> 7) * 256 + (c0 & 127) : ((c0 - 1024) >> 7) * 256 + 128 + ((c0 - 1024) & 127);
    pg8::SideCvt sd;
    sd.sbase = pg8::uptr((const char*)(a.in[14] + (size_t)e * 1024 * 2048 + c0));
    sd.dbase = (unsigned char*)pg8::uptr((const char*)(a.ws + WS_WTGU + (size_t)(e * 2048 + drow) * 1024));
    const int l = F.lane;
    sd.voffs = (unsigned)((16 * ((l & 15) >> 2) + 4 * (l >> 4)) * 8192 + (l & 3) * 16); sd.voffd = (unsigned)((l >> 2) * 1024 + (l & 3) * 16); sd.lrd = (unsigned)((l & 3) * 64 + (l >> 2) * 4);
    sd.slot = RING_BYTES + F.wave * 4096; sd.left = n; sd.ji = j0; sd.js = j0; sd.sw = S_W;
    return sd;
}
__device__ __forceinline__ void phase0(const Args& a, Frame& F) {
    float* mod = (float*)(a.ws + WS_MOD);
    {
        LAS float* red = (LAS float*)F.lds;
        const float* cvec = a.in[1]; const float* W = a.in[2];
        if (F.bid == F.G - 1) {
            bf16* WH = (bf16*)(a.ws + WS_WRT); bf16* WL = WH + 32 * 1024;
            float rv[64];
#pragma unroll
            for (int j = 0; j < 64; ++j) rv[j] = a.in[12][F.tid + j * (NWAVES * 64)];
#pragma unroll
            for (int j = 0; j < 64; ++j) { const int i = F.tid + j * (NWAVES * 64); const int k = i >> 5, e = i & 31; const float v = rv[j]; const unsigned h16 = ab::cvtpk_s(v, 0.f) & 0xffffu; const float r = v - __uint_as_float(h16 << 16);
                WH[e * 1024 + k] = (bf16)h16; WL[e * 1024 + k] = (bf16)(ab::cvtpk_s(r, 0.f) & 0xffffu); }
        }
        if (F.bid == (F.G > 1 ? F.G - 2 : 0)) { float* WFT = (float*)(a.ws + WS_WFT);
            for (int col = F.tid; col < 1024; col += NWAVES * 64) { const float* p = a.in[6] + (size_t)col * INW + 3072; const f32x4 u = *(const f32x4*)p, w = *(const f32x4*)(p + 4);
                WFT[0 * 1024 + col] = u[0]; WFT[1 * 1024 + col] = u[1]; WFT[2 * 1024 + col] = u[2]; WFT[3 * 1024 + col] = u[3];
                WFT[4 * 1024 + col] = w[0]; WFT[5 * 1024 + col] = w[1]; WFT[6 * 1024 + col] = w[2]; WFT[7 * 1024 + col] = w[3]; } }
        for (int cb = F.bid; cb < 192; cb += F.G) {
            const int col = cb * 32 + (F.lane & 31), kh = F.lane >> 5;
            float acc = 0.f; float wv[64];
#pragma unroll
            for (int i = 0; i < 64; ++i) wv[i] = __builtin_nontemporal_load(W + (size_t)(F.wave * 128 + 2 * i + kh) * 6144 + col);
#pragma unroll
            for (int i = 0; i < 64; ++i) { const float cv = cvec[F.wave * 128 + 2 * i + kh]; acc += (cv / (1.0f + __expf(-cv))) * wv[i]; }
            acc += __shfl_xor(acc, 32);
            if (F.lane < 32) red[F.wave * 32 + F.lane] = acc;
            __syncthreads();
            if (F.tid < 32) { float s = 0.f;
#pragma unroll
                for (int w = 0; w < 8; ++w) s += red[w * 32 + F.tid];
                mod[cb * 32 + F.tid] = s + a.in[3][cb * 32 + F.tid]; }
            __syncthreads();
        }
    }
    {
        LAS float* scr = (LAS float*)(F.lds + (F.wave < 7 ? F.wave * 16640 : X_OFF));
        const int ngu = side_gu(F.G) ? 0 : 2048, nitems = CVT_NITEMS - 2048 + ngu;
        const int per = (nitems + F.G - 1) / F.G;
        const int it0 = F.bid * per, it1 = (it0 + per < nitems) ? it0 + per : nitems;
        const int n4 = (F.lane & 15) * 4, kr = F.lane >> 4, kg8 = F.lane & 7, nn = F.lane >> 3;
        f32x4 va[16], vb[16]; CvtItem ca, cb;
#define CVT_LOAD(vv, cc, ii) do { if ((ii) < it1) { cc = cvt_decode(a, (ii), F.wave, ngu); _Pragma("unroll") for (int p = 0; p < 16; ++p) vv[p] = __builtin_nontemporal_load((const f32x4*)(cc.src + (size_t)(kr + 4 * p) * cc.ldn + n4)); } } while (0)
#define CVT_ITEM(vv, cc, ii) do { \
            _Pragma("unroll") for (int p = 0; p < 16; ++p) { LAS float* s_ = scr + (kr + 4 * p) * 65 + n4; s_[0] = vv[p][0]; s_[1] = vv[p][1]; s_[2] = vv[p][2]; s_[3] = vv[p][3]; } \
            unsigned char* dst_ = cc.dst; const int esz_ = cc.esz; ii += 2; CVT_LOAD(vv, cc, ii); \
            asm volatile("s_waitcnt lgkmcnt(0)" ::: "memory"); \
            _Pragma("unroll") for (int q = 0; q < 8; ++q) { const int n_ = nn + 8 * q; const LAS float* s_ = scr + (8 * kg8) * 65 + n_; \
                if (esz_ == 2) { u32x4 o_; o_.x = ab::cvtpk_s(s_[0], s_[65]); o_.y = ab::cvtpk_s(s_[130], s_[195]); o_.z = ab::cvtpk_s(s_[260], s_[325]); o_.w = ab::cvtpk_s(s_[390], s_[455]); \
                    *(u32x4*)(dst_ + ((size_t)n_ * 1024 + 8 * kg8) * 2) = o_; } \
                else { u32x2 o_; o_.x = f8pk4(s_[0] * S_W, s_[65] * S_W, s_[130] * S_W, s_[195] * S_W); o_.y = f8pk4(s_[260] * S_W, s_[325] * S_W, s_[390] * S_W, s_[455] * S_W); \
                    *(u32x2*)(dst_ + (size_t)n_ * 1024 + 8 * kg8) = o_; } } \
            asm volatile("s_waitcnt lgkmcnt(0)" ::: "memory"); } while (0)
        int ita = it0, itb = it0 + 1;
        CVT_LOAD(va, ca, ita); CVT_LOAD(vb, cb, itb);
        while (ita < it1) {
            CVT_ITEM(va, ca, ita);
            if (itb < it1) CVT_ITEM(vb, cb, itb);
        }
#undef CVT_LOAD
#undef CVT_ITEM
        __syncthreads();
    }
}

__device__ __forceinline__ void phase1(const Args& a, Frame& F) {
    const float* mod = (const float*)(a.ws + WS_MOD);
    LAS float* wfT = (LAS float*)F.lds;
    LAS float* totw = (LAS float*)(F.lds + 32768);
    { const f32x4* WFT = (const f32x4*)(a.ws + WS_WFT); f32x4 wv[4];
#pragma unroll
      for (int i = 0; i < 4; ++i) wv[i] = WFT[F.tid + 512 * i];
#pragma unroll
      for (int i = 0; i < 4; ++i) *(LAS f32x4*)(wfT + 4 * (F.tid + 512 * i)) = wv[i]; }
    f32x4 A[4], B[4];
#pragma unroll
    for (int j = 0; j < 4; ++j) { const int c = 256 * j + 4 * F.lane; const f32x4 g = *(const f32x4*)(a.in[4] + c), sc = *(const f32x4*)(mod + 1024 + c); A[j] = g * (sc + 1.0f); B[j] = *(const f32x4*)(mod + c); }
    const float bfg = a.in[7][F.lane >> 3];
    __syncthreads();
    bf16* __restrict__ XN = (bf16*)(a.ws + WS_XN); float* __restrict__ LOGF = (float*)(a.ws + WS_LOGF); float* TOT = (float*)(a.ws + WS_TOT);
    const float* __restrict__ xin = a.in[0];
    for (int c_ = F.bid; c_ < NCHUNK; c_ += F.G) { const int c = vchunk(c_, F.G);
        float tot = 0.f;
        auto LOADROW = [&](int rr, f32x4 (&vv)[4]) __attribute__((always_inline)) { const bool ok = rr < 8;
            const float* xr = xin + (size_t)(c * CHR + F.wave * 8 + (ok ? rr : 7)) * DM + (ok ? 4 * F.lane : 0);
#pragma unroll
            for (int j = 0; j < 4; ++j) vv[j] = __builtin_nontemporal_load((const f32x4*)(xr + 256 * j)); };
        auto ROW = [&](int rr, const f32x4 (&vin)[4]) __attribute__((always_inline)) {
            const int row = c * CHR + F.wave * 8 + rr;
            f32x4 v[4]; float ss = 0.f;
#pragma unroll
            for (int j = 0; j < 4; ++j) { v[j] = vin[j]; ss += (v[j][0] * v[j][0] + v[j][1] * v[j][1]) + (v[j][2] * v[j][2] + v[j][3] * v[j][3]); }
            const float rstd = 1.0f / sqrtf(wave_sum(ss) * (1.0f / DM) + RMS_EPS);
            bf16* orow = XN + (size_t)row * DM + 4 * F.lane;
#pragma unroll
            for (int j = 0; j < 4; ++j) { v[j] = (v[j] * rstd) * A[j] + B[j]; u32x2 o; o.x = ab::cvtpk_s(v[j][0], v[j][1]); o.y = ab::cvtpk_s(v[j][2], v[j][3]); *(u32x2*)(orow + 256 * j) = o; }
            float pe[8];
#pragma unroll
            for (int e = 0; e < 8; ++e) { float s = 0.f;
#pragma unroll
                for (int j = 0; j < 4; ++j) { const f32x4 w = *(const LAS f32x4*)(wfT + e * 1024 + 256 * j + 4 * F.lane); s += (v[j][0] * w[0] + v[j][1] * w[1]) + (v[j][2] * w[2] + v[j][3] * w[3]); }
                pe[e] = s; }
            float q4[4], q2[2];
            { const int b5 = F.lane >> 5, b4 = (F.lane >> 4) & 1, b3 = (F.lane >> 3) & 1;
#pragma unroll
              for (int i = 0; i < 4; ++i) { const float send = b5 ? pe[i] : pe[4 + i], keep = b5 ? pe[4 + i] : pe[i]; q4[i] = keep + __shfl_xor(send, 32); }
#pragma unroll
              for (int i = 0; i < 2; ++i) { const float send = b4 ? q4[i] : q4[2 + i], keep = b4 ? q4[2 + i] : q4[i]; q2[i] = keep + __shfl_xor(send, 16); }
              const float send = b3 ? q2[0] : q2[1], keep = b3 ? q2[1] : q2[0]; float z = keep + __shfl_xor(send, 8);
              z += __shfl_xor(z, 4); z += __shfl_xor(z, 2); z += __shfl_xor(z, 1);
              z += bfg;
              const float lf = fminf(z, 0.f) - log1pf(expf(-fabsf(z)));
              if ((F.lane & 7) == 0) { LOGF[(size_t)row * 8 + (F.lane >> 3)] = lf; tot += lf; } }
        };
        f32x4 va[4], vb[4];
        LOADROW(0, va);
#pragma unroll 1
        for (int rr = 0; rr < 8; rr += 2) { LOADROW(rr + 1, vb); ROW(rr, va); LOADROW(rr + 2, va); ROW(rr + 1, vb); }
        if ((F.lane & 7) == 0) totw[F.wave * 8 + (F.lane >> 3)] = tot;
        __syncthreads();
        if (F.tid < 8) { float s = 0.f;
#pragma unroll
            for (int w = 0; w < 8; ++w) s += totw[w * 8 + F.tid];
            TOT[c * 8 + F.tid] = s; }
        __syncthreads();
    }
}

__device__ __forceinline__ void cum_chunks(const Args& a, Frame& F) {
    const float* LOGF = (const float*)(a.ws + WS_LOGF); const float* TOT = (const float*)(a.ws + WS_TOT); float* CUM = (float*)(a.ws + WS_CUM);
    for (int c_ = F.bid; c_ < NCHUNK; c_ += F.G) { const int c = vchunk(c_, F.G);
        const int h = F.wave;
        float tv[4];
#pragma unroll
        for (int i = 0; i < 4; ++i) tv[i] = TOT[(F.lane + 64 * i) * 8 + h];
        float x = LOGF[(size_t)(c * CHR + F.lane) * 8 + h];
        double s = 0.0;
#pragma unroll
        for (int i = 0; i < 4; ++i) { const int cc = F.lane + 64 * i; s += cc < c ? (double)tv[i] : 0.0; }
        s = wave_sum_d(s);
#pragma unroll
        for (int o = 1; o < 64; o <<= 1) { const float y = __shfl_up(x, o); if (F.lane >= o) x += y; }
        CUM[(size_t)(c * CHR + F.lane) * 8 + h] = (float)(s + (double)x);
    }
}

__device__ __forceinline__ void qkt2(f32x16& p0, f32x16& p1, LAS const unsigned char* kslot, const bf16x8* qr, const f32x16& c0, const f32x16& c1, int r32, int hi) {
    LAS const unsigned char* kb = kslot + hi * 1024 + r32 * 16;
#pragma unroll
    for (int d0 = 0; d0 < 4; ++d0) {
        const bf16x8 b0 = *(LAS const bf16x8*)(kb + d0 * 2048), b1 = *(LAS const bf16x8*)(kb + d0 * 2048 + 512);
        if (d0 == 0) { p0 = __builtin_amdgcn_mfma_f32_32x32x16_bf16(b0, qr[0], c0, 0, 0, 0); p1 = __builtin_amdgcn_mfma_f32_32x32x16_bf16(b1, qr[0], c1, 0, 0, 0); }
        else { p0 = __builtin_amdgcn_mfma_f32_32x32x16_bf16(b0, qr[d0], p0, 0, 0, 0); p1 = __builtin_amdgcn_mfma_f32_32x32x16_bf16(b1, qr[d0], p1, 0, 0, 0); }
    }
}
__device__ __forceinline__ float moff_of(float m) { return m > -1e29f ? m : 0.f; }
__device__ __forceinline__ void softmax_pv(f32x16& p0, f32x16& p1, float& m, float& l, f32x16 (&o)[2], LAS float* wsf, int vb, int r32, int hi, float mrel) {
    asm volatile("s_nop 15\n\ts_nop 7" : "+v"(p0), "+v"(p1));
    const float rm = ab::rowmax(p0, p1);
    const bool first = !(m > -1e29f);
    const bool grow = first ? (rm > -1e29f) : (rm + mrel > m + 8.0f);
    if (__any(grow)) {
        const float mn = grow ? rm + mrel : m;
        const float f = __builtin_amdgcn_exp2f(m - mn);
        m = mn; l *= f;
        asm volatile("" ::: "memory");
        if (hi == 0) wsf[r32] = f;
        asm volatile("" ::: "memory");
#pragma unroll
        for (int g = 0; g < 4; ++g) { const f32x4 fr = *(LAS const f32x4*)(wsf + 8 * g + 4 * hi);
#pragma unroll
            for (int k = 0; k < 4; ++k) { o[0][4 * g + k] *= fr[k]; o[1][4 * g + k] *= fr[k]; } }
        asm volatile("" ::: "memory");
    }
    { const float dlt = (m > -1e29f) ? m - mrel : 0.f;
      if (__any(dlt != 0.f)) {
#pragma unroll
          for (int r = 0; r < 16; ++r) { p0[r] -= dlt; p1[r] -= dlt; } } }
    float s = 0.f;
#pragma unroll
    for (int r = 0; r < 16; ++r) { p0[r] = __builtin_amdgcn_exp2f(p0[r]); p1[r] = __builtin_amdgcn_exp2f(p1[r]); s += p0[r] + p1[r]; }
    l += s;
    u32x4 pw0, pw1, pw2, pw3;
    pw0 = (u32x4){ab::cvtpk_s(p0[0], p0[1]), ab::cvtpk_s(p0[2], p0[3]), ab::cvtpk_s(p0[4], p0[5]), ab::cvtpk_s(p0[6], p0[7])};
    pw1 = (u32x4){ab::cvtpk_s(p0[8], p0[9]), ab::cvtpk_s(p0[10], p0[11]), ab::cvtpk_s(p0[12], p0[13]), ab::cvtpk_s(p0[14], p0[15])};
    pw2 = (u32x4){ab::cvtpk_s(p1[0], p1[1]), ab::cvtpk_s(p1[2], p1[3]), ab::cvtpk_s(p1[4], p1[5]), ab::cvtpk_s(p1[6], p1[7])};
    pw3 = (u32x4){ab::cvtpk_s(p1[8], p1[9]), ab::cvtpk_s(p1[10], p1[11]), ab::cvtpk_s(p1[12], p1[13]), ab::cvtpk_s(p1[14], p1[15])};
    __builtin_amdgcn_sched_barrier(0);
    ab::pv(o, vb, __builtin_bit_cast(bf16x8, pw0), __builtin_bit_cast(bf16x8, pw1), __builtin_bit_cast(bf16x8, pw2), __builtin_bit_cast(bf16x8, pw3));
}
__device__ __forceinline__ void stage_o(const f32x16 (&o)[2], const float (&rli)[16], LAS bf16* stg, int r32, int hi) {
#pragma unroll
    for (int r = 0; r < 16; ++r) { const int orow = ab::crow(r, hi);
#pragma unroll
        for (int d0 = 0; d0 < 2; ++d0) stg[orow * 64 + d0 * 32 + r32] = (bf16)(ab::cvtpk_s(o[d0][r] * rli[r], 0.f) & 0xffffu); }
}

__device__ __forceinline__ void glds4(const void* gsrc, unsigned lds_dst) { unsigned keep;
    asm volatile("s_mov_b32 %0, m0\n\ts_mov_b32 m0, %2\n\ts_nop 0\n\tglobal_load_lds_dword %1, off\n\ts_mov_b32 m0, %0" : "=&s"(keep) : "v"(gsrc), "s"(lds_dst) : "memory"); }
__device__ __forceinline__ void fox_unit(const Args& a, Frame& F, int h, int qb) {
    const bf16* P = (const bf16*)(a.ws + WS_PROJ); const float* CUM = (const float*)(a.ws + WS_CUM);
    const int lane = F.lane, r32 = lane & 31, hi = lane >> 5, wid = F.wave, t0 = qb * 256;
    const float qn = __uint_as_float(__hip_atomic_load(F.ctl + CW_QN2H + (qb * 8 + h) * 2, RLX_AGENT)) + __uint_as_float(__hip_atomic_load(F.ctl + CW_QN2H + (qb * 8 + h) * 2 + 1, RLX_AGENT));
    const float kn = __uint_as_float(__hip_atomic_load(F.ctl + CW_KN2H + h * 2, RLX_AGENT)) + __uint_as_float(__hip_atomic_load(F.ctl + CW_KN2H + h * 2 + 1, RLX_AGENT));
    const float bnd = 2.0f * sqrtf(qn) * sqrtf(kn) * 1.01f + 0.05f;
    const float Ct0 = CUM[(size_t)t0 * 8 + h], Cref = CUM[(size_t)(t0 + 255) * 8 + h];
    const int base0 = 4 * qb - 1; const int j0c = base0 - lane > 0 ? base0 - lane : 0;
    const float cv0 = CUM[(size_t)(64 * j0c + 63) * 8 + h];
    const bf16* Qw = P + (size_t)(t0 + wid * 32 + r32) * PITCH + OFF_QA + h * 64;
    bf16x8 qr[4];
#pragma unroll
    for (int d0 = 0; d0 < 4; ++d0) qr[d0] = *(const bf16x8*)(Qw + d0 * 16 + hi * 8);
    int jmin = 0; bool found = false;
    for (int base = base0; base >= 0 && !found; base -= 64) {
        const int j = base - lane; bool need = false;
        if (base == base0) { if (j >= 0) need = (bnd + (Ct0 - cv0) * LOG2E) >= -44.5f; }
        else if (j >= 0) need = (bnd + (Ct0 - CUM[(size_t)(64 * j + 63) * 8 + h]) * LOG2E) >= -44.5f;
        const unsigned long long mk = __ballot(need);
        if (mk == 0ull) { jmin = base + 1; found = true; }
        else { const int hb = 63 - __builtin_clzll(mk); if (hb < 63) { jmin = base - hb; found = true; } }
    }
    jmin = __builtin_amdgcn_readfirstlane(jmin);
    const int NT = 4 * qb + 4, nt = NT - jmin;
    float m = -1e30f, l = 0.f; f32x16 o[2]; o[0] = f32x16{}; o[1] = f32x16{};
    const bf16* ksrc = P + OFF_KA + h * 64 + (size_t)lane * PITCH + wid * 8;
    const bf16* vsrc = P + OFF_VA + h * 64 + (size_t)(16 * (wid & 3) + (lane >> 2)) * PITCH + (wid >> 2) * 32 + (lane & 3) * 8;
    const float* csrc = CUM + (size_t)lane * 8 + h;
    const unsigned kdst = lds_addr(F.lds + A_K) + wid * 1024, vdst = lds_addr(F.lds + A_V) + wid * 1024, cdst = lds_addr(F.lds + X_OFF + 8192);
    LAS const float* cring = (LAS const float*)(F.lds + X_OFF + 8192); LAS float* wsf = (LAS float*)(F.lds + A_WS) + wid * 64;
    const int vb = (int)lds_addr(F.lds + A_V) + ((lane >> 4) & 1) * 32 + (lane & 3) * 8 + (4 * hi + ((lane & 15) >> 2)) * 64;
#define FOX_ISSUE(i_) do { const int j_ = jmin + (i_); const unsigned so_ = (unsigned)((i_) & 3); \
        ab::glds16(ksrc + (size_t)j_ * 64 * PITCH, (unsigned)__builtin_amdgcn_readfirstlane(kdst + so_ * 8192)); ab::glds16(vsrc + (size_t)j_ * 64 * PITCH, (unsigned)__builtin_amdgcn_readfirstlane(vdst + so_ * 8192)); \
        if (wid == 0) glds4(csrc + (size_t)j_ * 64 * 8, (unsigned)__builtin_amdgcn_readfirstlane(cdst + so_ * 256)); } while (0)
    __syncthreads();
    FOX_ISSUE(0); if (nt > 1) FOX_ISSUE(1); if (nt > 2) FOX_ISSUE(2);
    for (int i = 0; i < nt; ++i) {
        const int ahead = (nt - 1 - i) < 2 ? (nt - 1 - i) : 2;
        if (wid == 0) { if (ahead == 2) asm volatile("s_waitcnt vmcnt(6)" ::: "memory"); else if (ahead == 1) asm volatile("s_waitcnt vmcnt(3)" ::: "memory"); else asm volatile("s_waitcnt vmcnt(0)" ::: "memory"); }
        else { if (ahead == 2) asm volatile("s_waitcnt vmcnt(4)" ::: "memory"); else if (ahead == 1) asm volatile("s_waitcnt vmcnt(2)" ::: "memory"); else asm volatile("s_waitcnt vmcnt(0)" ::: "memory"); }
        __syncthreads();
        if (i + 3 < nt) FOX_ISSUE(i + 3);
        const int so = i & 3, j = jmin + i;
        f32x16 c0, c1; const float crl = Cref * LOG2E - moff_of(m);
#pragma unroll
        for (int g = 0; g < 4; ++g) { const f32x4 b0 = *(LAS const f32x4*)(cring + so * 64 + 8 * g + 4 * hi), b1 = *(LAS const f32x4*)(cring + so * 64 + 32 + 8 * g + 4 * hi);
#pragma unroll
            for (int k = 0; k < 4; k += 2) { typedef float f32x2v __attribute__((ext_vector_type(2))); const f32x2v nl = {-LOG2E, -LOG2E}, cr2 = {crl, crl};
                const f32x2v u0 = (f32x2v){b0[k], b0[k + 1]} * nl + cr2, u1 = (f32x2v){b1[k], b1[k + 1]} * nl + cr2;
                c0[4 * g + k] = u0[0]; c0[4 * g + k + 1] = u0[1]; c1[4 * g + k] = u1[0]; c1[4 * g + k + 1] = u1[1]; } }
        f32x16 p0, p1;
        qkt2(p0, p1, F.lds + A_K + so * 8192, qr, c0, c1, r32, hi);
        const int jb = j - (NT - 4);
        if (jb >= 0) ab::cmask(p0, p1, jb, wid * 32 + r32, hi);
        softmax_pv(p0, p1, m, l, o, wsf, vb + so * 8192, r32, hi, moff_of(m));
    }
#undef FOX_ISSUE
    { auto rr = __builtin_amdgcn_permlane32_swap(__float_as_uint(l), __float_as_uint(l), false, false); l = __uint_as_float(rr[0]) + __uint_as_float(rr[1]); }
    asm volatile("" ::: "memory");
    if (hi == 0) wsf[32 + r32] = l;
    asm volatile("" ::: "memory");
    float rli[16];
#pragma unroll
    for (int r = 0; r < 16; ++r) rli[r] = __builtin_amdgcn_rcpf(wsf[32 + ab::crow(r, hi)]);
    LAS bf16* stg = (LAS bf16*)(F.lds + A_OST) + wid * 2048;
    stage_o(o, rli, stg, r32, hi);
    asm volatile("s_waitcnt lgkmcnt(0)" ::: "memory");
    bf16* Ow = (bf16*)(a.ws + WS_MIX) + (size_t)(t0 + wid * 32) * DM + h * 64;
#pragma unroll
    for (int i = 0; i < 4; ++i) { const int row = i * 8 + (lane >> 3), ch = lane & 7; const u32x4 v = *(LAS const u32x4*)(stg + row * 64 + ch * 8); *(u32x4*)(Ow + (size_t)row * DM + ch * 8) = v; }
}

__device__ __forceinline__ void moba_build_kmean(const Args& a, Frame& F) {
    const float* KMS = (const float*)(F.ctl + CW_KMS);
    const int h = F.tid >> 6, d = F.tid & 63;
    LAS bf16* km = (LAS bf16*)(F.lds + h * 8192 + (d >> 3) * 1024 + (d & 7) * 2);
    float sv[NMB];
#pragma unroll
    for (int n = 0; n < NMB; ++n) sv[n] = KMS[((size_t)h * 64 + n) * 64 + d];
#pragma unroll
    for (int n = 0; n < NMB; ++n) { const float s = sv[n] * (1.0f / 256.0f); km[n * 8] = (bf16)(ab::cvtpk_s(s, 0.f) & 0xffffu); }
    __syncthreads();
}
#define TOP3_INS(g, n) do { const float g_ = (g); const int n_ = (n); \
    if (g_ > v1 || (g_ == v1 && n_ < i1)) { v3 = v2; i3 = i2; v2 = v1; i2 = i1; v1 = g_; i1 = n_; } \
    else if (g_ > v2 || (g_ == v2 && n_ < i2)) { v3 = v2; i3 = i2; v2 = g_; i2 = n_; } \
    else if (g_ > v3 || (g_ == v3 && n_ < i3)) { v3 = g_; i3 = n_; } } while (0)
__device__ __forceinline__ void moba_gate_task(const Args& a, Frame& F, int h, int t0, int own) {
    const bf16* P = (const bf16*)(a.ws + WS_PROJ);
    const int lane = F.lane, r32 = lane & 31, hi = lane >> 5, t = t0 + r32;
    bf16x8 qr[4];
    { const bf16* Qw = P + (size_t)t * PITCH + OFF_QB + h * 64;
#pragma unroll
      for (int d0 = 0; d0 < 4; ++d0) qr[d0] = *(const bf16x8*)(Qw + d0 * 16 + hi * 8); }
    f32x16 z;
#pragma unroll
    for (int r = 0; r < 16; ++r) z[r] = 0.f;
    f32x16 p0, p1;
    qkt2(p0, p1, F.lds + h * 8192, qr, z, z, r32, hi);
    float v1 = -INFINITY, v2 = -INFINITY, v3 = -INFINITY; int i1 = 1 << 20, i2 = 1 << 20, i3 = 1 << 20;
#pragma unroll
    for (int r = 0; r < 16; ++r) { const int n = ab::crow(r, hi); const float g = n < own ? p0[r] : -INFINITY; if (g > -INFINITY) TOP3_INS(g, n); }
#pragma unroll
    for (int r = 0; r < 16; ++r) { const int n = 32 + ab::crow(r, hi); const float g = n < own ? p1[r] : -INFINITY; if (g > -INFINITY) TOP3_INS(g, n); }
    { const float w1 = __shfl_xor(v1, 32), w2 = __shfl_xor(v2, 32), w3 = __shfl_xor(v3, 32); const int j1 = __shfl_xor(i1, 32), j2 = __shfl_xor(i2, 32), j3 = __shfl_xor(i3, 32);
      if (w1 > -INFINITY) TOP3_INS(w1, j1);
      if (w2 > -INFINITY) TOP3_INS(w2, j2);
      if (w3 > -INFINITY) TOP3_INS(w3, j3); }
    if (v1 == -INFINITY) i1 = -1;
    if (v2 == -INFINITY) i2 = -1;
    if (v3 == -INFINITY) i3 = -1;
    LAS int* cnt = (LAS int*)(F.lds + X_OFF) + F.wave * 128; LAS int* gb = cnt + 64;
    cnt[lane] = 0;
    asm volatile("s_waitcnt lgkmcnt(0)" ::: "memory");
    int r1 = 0, r2 = 0, r3 = 0;
    if (hi == 0) {
        if (i1 >= 0) r1 = (int)__hip_atomic_fetch_add(cnt + i1, 1, __ATOMIC_RELAXED, __HIP_MEMORY_SCOPE_WORKGROUP);
        if (i2 >= 0) r2 = (int)__hip_atomic_fetch_add(cnt + i2, 1, __ATOMIC_RELAXED, __HIP_MEMORY_SCOPE_WORKGROUP);
        if (i3 >= 0) r3 = (int)__hip_atomic_fetch_add(cnt + i3, 1, __ATOMIC_RELAXED, __HIP_MEMORY_SCOPE_WORKGROUP);
    }
    asm volatile("s_waitcnt lgkmcnt(0)" ::: "memory");
    { const int cn = cnt[lane]; int b = 0; if (cn > 0) b = (int)__hip_atomic_fetch_add((unsigned*)(F.ctl + CW_GCNT + h * 64 + lane), (unsigned)cn, __ATOMIC_RELAXED, __HIP_MEMORY_SCOPE_AGENT); gb[lane] = b; }
    asm volatile("s_waitcnt vmcnt(0) lgkmcnt(0)" ::: "memory");
    if (hi == 0) {
        int* ML = (int*)(a.ws + WS_MLIST) + (size_t)h * LCAP;
        if (i1 >= 0) __hip_atomic_store(ML + 256 * (63 * i1 - (i1 * (i1 - 1)) / 2) + gb[i1] + r1, t * 4 + 0, __ATOMIC_RELAXED, __HIP_MEMORY_SCOPE_AGENT);
        if (i2 >= 0) __hip_atomic_store(ML + 256 * (63 * i2 - (i2 * (i2 - 1)) / 2) + gb[i2] + r2, t * 4 + 1, __ATOMIC_RELAXED, __HIP_MEMORY_SCOPE_AGENT);
        if (i3 >= 0) __hip_atomic_store(ML + 256 * (63 * i3 - (i3 * (i3 - 1)) / 2) + gb[i3] + r3, t * 4 + 2, __ATOMIC_RELAXED, __HIP_MEMORY_SCOPE_AGENT);
    }
    asm volatile("s_waitcnt vmcnt(0) lgkmcnt(0)" ::: "memory");
}

constexpr int A_LUT4 = 121600, LUT4_STRIDE = 2080;
static_assert(A_LUT4 + 4 * LUT4_STRIDE <= RING_BYTES && A_LUT4 >= 116992 + (520 + 512) * 4, "LUT4 inside the ring region, behind the prefix table");
__device__ __forceinline__ void build_lut4(Frame& F, int h) {
    LAS const float* lut = (LAS const float*)(F.lds + A_LUT) + h * 512; LAS float* c = (LAS float*)(F.lds + A_LUT4);
    for (int i = F.tid; i < 4 * 520; i += NWAVES * 64) { const int s_ = i / 520, j = i - s_ * 520; const int x = j + s_ - 4; c[s_ * 520 + j] = x < 0 ? -INFINITY : lut[min(x, 511)]; }
}
__device__ __forceinline__ void near_bias(f32x16& p0, f32x16& p1, LAS const unsigned char* lds, int D) {
#pragma unroll
    for (int g = 0; g < 4; ++g)
#pragma unroll
        for (int half = 0; half < 2; ++half) {
            const int E = D - 8 * g - 3 - 32 * half, Ec = min(max(E, -4), 508);
            const f32x4 q = *(LAS const f32x4*)(lds + A_LUT4 + (Ec & 3) * LUT4_STRIDE + ((Ec & ~3) + 4) * 4);
            typedef float f32x2v __attribute__((ext_vector_type(2)));
#pragma unroll
            for (int ii = 0; ii < 4; ii += 2) { const int r = 4 * g + ii; const f32x2v bb = {q[3 - ii], q[2 - ii]};
                if (half == 0) { const f32x2v w = (f32x2v){p0[r], p0[r + 1]} + bb; p0[r] = w[0]; p0[r + 1] = w[1]; }
                else { const f32x2v w = (f32x2v){p1[r], p1[r + 1]} + bb; p1[r] = w[0]; p1[r + 1] = w[1]; } } }
}
__device__ __forceinline__ void moba_item(const Args& a, Frame& F, int h, int n, bool own, const int* list, int cnt) {
    const bf16* P = (const bf16*)(a.ws + WS_PROJ);
    const int lane = F.lane, r32 = lane & 31, hi = lane >> 5, wid = F.wave;
    __syncthreads();
    { const bf16* ksrc = P + OFF_KB + h * 64 + (size_t)(256 * n + lane) * PITCH + wid * 8;
      const bf16* vsrc = P + OFF_VB + h * 64 + (size_t)(256 * n + 16 * (wid & 3) + (lane >> 2)) * PITCH + (wid >> 2) * 32 + (lane & 3) * 8;
      const unsigned kdst = lds_addr(F.lds + A_K) + wid * 1024, vdst = lds_addr(F.lds + A_V) + wid * 1024;
#pragma unroll
      for (int jt = 0; jt < 4; ++jt) { ab::glds16(ksrc + (size_t)jt * 64 * PITCH, (unsigned)__builtin_amdgcn_readfirstlane(kdst + jt * 8192)); ab::glds16(vsrc + (size_t)jt * 64 * PITCH, (unsigned)__builtin_amdgcn_readfirstlane(vdst + jt * 8192)); } }
    int nv = cnt - wid * 32; nv = nv < 0 ? 0 : (nv > 32 ? 32 : nv);
    int ent;
    if (own) ent = ((256 * n + wid * 32 + r32) << 2) | 3;
    else { int idx = wid * 32 + r32; if (idx >= cnt) idx = cnt - 1; ent = list[idx]; }
    const int t = ent >> 2;
    bf16x8 qr[4];
    { const bf16* Qw = P + (size_t)t * PITCH + OFF_QB + h * 64;
#pragma unroll
      for (int d0 = 0; d0 < 4; ++d0) qr[d0] = *(const bf16x8*)(Qw + d0 * 16 + hi * 8); }
    build_lut4(F, h);
    asm volatile("s_waitcnt vmcnt(0) lgkmcnt(0)" ::: "memory");
    __syncthreads();
    if (nv > 0) {
        LAS const float* lut = (LAS const float*)(F.lds + A_LUT) + h * 512;
        LAS float* wsf = (LAS float*)(F.lds + A_WS) + wid * 64;
        const bool anynear = __any(t < 256 * (n + 2)) != 0;
        const float rb31 = lut[511];
        float m = -1e30f, l = 0.f; f32x16 o[2]; o[0] = f32x16{}; o[1] = f32x16{};
        const int vb0 = (int)lds_addr(F.lds + A_V) + ((lane >> 4) & 1) * 32 + (lane & 3) * 8 + (4 * hi + ((lane & 15) >> 2)) * 64;
        for (int jt = 0; jt < 4; ++jt) {
            if (own && 64 * jt > wid * 32 + 31) break;
            f32x16 cc;
            const bool near_t = anynear && __any(t < 256 * n + 64 * jt + 63 + 113) != 0;
            const float ci = (near_t ? 0.f : rb31) - moff_of(m);
#pragma unroll
            for (int r = 0; r < 16; ++r) cc[r] = ci;
            f32x16 p0, p1;
            qkt2(p0, p1, F.lds + A_K + jt * 8192, qr, cc, cc, r32, hi);
            if (near_t) { const int D = t - (256 * n + 64 * jt + 4 * hi);
                near_bias(p0, p1, F.lds, D); }
            softmax_pv(p0, p1, m, l, o, wsf, vb0 + jt * 8192, r32, hi, moff_of(m));
        }
        { auto rr = __builtin_amdgcn_permlane32_swap(__float_as_uint(l), __float_as_uint(l), false, false); l = __uint_as_float(rr[0]) + __uint_as_float(rr[1]); }
        float rli[16];
#pragma unroll
        for (int r = 0; r < 16; ++r) rli[r] = 1.0f;
        LAS bf16* stg = (LAS bf16*)(F.lds + A_OST) + wid * 2048;
        stage_o(o, rli, stg, r32, hi);
        asm volatile("s_waitcnt lgkmcnt(0)" ::: "memory");
        const bf16* PO = (const bf16*)(a.ws + WS_PO); const float* PM = (const float*)(a.ws + WS_PM); const float* PL = (const float*)(a.ws + WS_PL);
        bf16* MIX = (bf16*)(a.ws + WS_MIX);
        const int nsel = n < 3 ? n : 3;
        float mi[4][3], li[4][3]; u32x4 pv_[4][3];
#pragma unroll
        for (int i = 0; i < 4; ++i) { const int row = i * 8 + (lane >> 3), ch = lane & 7; const int tr = 256 * n + wid * 32 + row; const size_t pb = ((size_t)h * SEQ + tr) * 4;
#pragma unroll
            for (int k = 0; k < 3; ++k) { const bool valid = k < nsel; { typedef float f32x2m __attribute__((ext_vector_type(2))); const f32x2m ml = valid ? ((const f32x2m*)PM)[pb + k] : (f32x2m){-INFINITY, 0.f}; mi[i][k] = ml[0]; li[i][k] = ml[1]; } pv_[i][k] = valid ? __builtin_nontemporal_load((const u32x4*)(PO + (pb + k) * 64 + ch * 8)) : (u32x4){0u, 0u, 0u, 0u}; } }
#pragma unroll
        for (int i = 0; i < 4; ++i) { const int row = i * 8 + (lane >> 3), ch = lane & 7; const int tr = 256 * n + wid * 32 + row;
            const float mo = __shfl(m, row), lo_ = __shfl(l, row);
            const u32x4 v = *(LAS const u32x4*)(stg + row * 64 + ch * 8);
            float M = mo;
#pragma unroll
            for (int k = 0; k < 3; ++k) M = fmaxf(M, mi[i][k]);
            const float wo = __builtin_amdgcn_exp2f(mo - M); float L = wo * lo_; float acc[8];
#pragma unroll
            for (int k = 0; k < 4; ++k) { acc[2 * k] = wo * __uint_as_float(v[k] << 16); acc[2 * k + 1] = wo * __uint_as_float(v[k] & 0xffff0000u); }
#pragma unroll
            for (int k = 0; k < 3; ++k) { const float w = __builtin_amdgcn_exp2f(mi[i][k] - M); L += w * li[i][k];
#pragma unroll
                for (int q = 0; q < 4; ++q) { acc[2 * q] += w * __uint_as_float(pv_[i][k][q] << 16); acc[2 * q + 1] += w * __uint_as_float(pv_[i][k][q] & 0xffff0000u); } }
            const float inv = 1.0f / L;
            u32x4 ov; ov.x = ab::cvtpk_s(acc[0] * inv, acc[1] * inv); ov.y = ab::cvtpk_s(acc[2] * inv, acc[3] * inv); ov.z = ab::cvtpk_s(acc[4] * inv, acc[5] * inv); ov.w = ab::cvtpk_s(acc[6] * inv, acc[7] * inv);
            *(u32x4*)(MIX + (size_t)tr * DM + 512 + h * 64 + ch * 8) = ov; }
    }
}

__device__ __forceinline__ void build_lut(const Args& a, Frame& F) {
    LAS float* lut = (LAS float*)(F.lds + A_LUT);
    for (int i = F.tid; i < 8 * 512; i += NWAVES * 64) { const int h = i >> 9, d = i & 511; lut[i] = a.in[8][t5_bucket(d) * 8 + h] * LOG2E; }
    __syncthreads();
}
__device__ __forceinline__ void phase4(const Args& a, Frame& F) {
    moba_build_kmean(a, F);
    for (int c_ = F.bid; c_ < NCHUNK; c_ += F.G) { const int c = c_; const int own = c >> 2;
        if (own > 0) { moba_gate_task(a, F, F.wave, c * CHR, own); moba_gate_task(a, F, F.wave, c * CHR + 32, own); } }
    __syncthreads();
    if (F.tid == 0) (void)__hip_atomic_fetch_add(F.ctl + CW_GATE, 1u, __ATOMIC_RELAXED, __HIP_MEMORY_SCOPE_AGENT);
    for (int u = F.bid; u < NH * 64; u += F.G) fox_unit(a, F, u & 7, u >> 3);
}
struct RItem { int pi, cnt; const int* list; };
__device__ __forceinline__ RItem p5_decode(const Args& a, Frame& F, LAS const int* pfx, int it, int from) {
    int lo = 0, hi = 512;
    if (from >= 0) { lo = from; while (pfx[lo + 1] <= it) ++lo; }
    else while (hi - lo > 1) { const int mid = (lo + hi) >> 1; if (pfx[mid] <= it) lo = mid; else hi = mid; }
    RItem r; r.pi = __builtin_amdgcn_readfirstlane(lo); const int g = it - __builtin_amdgcn_readfirstlane(pfx[lo]), h = r.pi >> 6, n = r.pi & 63;
    const int total = __builtin_amdgcn_readfirstlane(pfx[520 + r.pi]);
    int cnt = total - g * 256; r.cnt = cnt > 256 ? 256 : cnt;
    r.list = (const int*)(a.ws + WS_MLIST) + (size_t)h * LCAP + 256 * (63 * n - (n * (n - 1)) / 2) + g * 256;
    return r;
}
__device__ __forceinline__ int p5_ent(const RItem& r, int wid, int r32) { int idx = wid * 32 + r32; if (idx >= r.cnt) idx = r.cnt - 1; return r.list[idx]; }
__device__ __forceinline__ void p5_q(bf16x8 (&qr)[4], const bf16* P, int ent, int h, int hi) {
    const bf16* Qw = P + (size_t)(ent >> 2) * PITCH + OFF_QB + h * 64;
#pragma unroll
    for (int d0 = 0; d0 < 4; ++d0) qr[d0] = *(const bf16x8*)(Qw + d0 * 16 + hi * 8);
}
__device__ __forceinline__ void phase5(const Args& a, Frame& F, bool handoff) {
    build_lut(a, F);
    if (handoff) {
        if (F.tid == 0) { unsigned sp_ = 0; while (__hip_atomic_load(F.ctl + CW_GATE, __ATOMIC_RELAXED, __HIP_MEMORY_SCOPE_AGENT) < (unsigned)F.G) { __builtin_amdgcn_s_sleep(1); if (++sp_ > (1u << 24)) break; }
            __builtin_amdgcn_fence(__ATOMIC_ACQUIRE, "agent"); asm volatile("s_waitcnt vmcnt(0)" ::: "memory"); }
        __syncthreads(); }
    LAS int* pfx = (LAS int*)(F.lds + A_PFX); LAS int* wt = (LAS int*)(F.lds + X_OFF);
    const int gc = (int)__hip_atomic_load(F.ctl + CW_GCNT + F.tid, RLX_AGENT);
    { int v = (gc + 255) >> 8;
#pragma unroll
      for (int o = 1; o < 64; o <<= 1) { const int y = __shfl_up(v, o); if (F.lane >= o) v += y; }
      if (F.lane == 63) wt[F.wave] = v;
      __syncthreads();
      int off = 0;
      for (int w = 0; w < F.wave; ++w) off += wt[w];
      pfx[F.tid + 1] = off + v; pfx[520 + F.tid] = gc; if (F.tid == 0) pfx[0] = 0;
      __syncthreads(); }
    const int nitems = pfx[512], per = (nitems + F.G - 1) / F.G, it0 = F.bid * per, it1 = (it0 + per < nitems) ? it0 + per : nitems;
    if (it0 >= it1) return;
    const bf16* P = (const bf16*)(a.ws + WS_PROJ);
    const int lane = F.lane, r32 = lane & 31, hi = lane >> 5, wid = F.wave;
    LAS float* wsf = (LAS float*)(F.lds + A_WS) + wid * 64;
    LAS bf16* stg = (LAS bf16*)(F.lds + A_OST) + wid * 2048;
    const int vb0 = (int)lds_addr(F.lds + A_V) + ((lane >> 4) & 1) * 32 + (lane & 3) * 8 + (4 * hi + ((lane & 15) >> 2)) * 64;
    bf16* PO = (bf16*)(a.ws + WS_PO); float* PM = (float*)(a.ws + WS_PM); float* PL = (float*)(a.ws + WS_PL);
    RItem cur = p5_decode(a, F, pfx, it0, -1), nx = cur;
    int ent = p5_ent(cur, wid, r32), ent_n = ent; bf16x8 qr[4], qn[4];
    p5_q(qr, P, ent, cur.pi >> 6, hi);
    int staged = -1;
    for (int it = it0; it < it1; ++it) {
        const bool has_next = it + 1 < it1;
        if (has_next) { nx = p5_decode(a, F, pfx, it + 1, cur.pi); ent_n = p5_ent(nx, wid, r32); }
        const int h = cur.pi >> 6, n = cur.pi & 63;
        if (cur.pi != staged) {
            __syncthreads();
            const bf16* ksrc = P + OFF_KB + h * 64 + (size_t)(256 * n + lane) * PITCH + wid * 8;
            const bf16* vsrc = P + OFF_VB + h * 64 + (size_t)(256 * n + 16 * (wid & 3) + (lane >> 2)) * PITCH + (wid >> 2) * 32 + (lane & 3) * 8;
            const unsigned kdst = lds_addr(F.lds + A_K) + wid * 1024, vdst = lds_addr(F.lds + A_V) + wid * 1024;
#pragma unroll
            for (int jt = 0; jt < 4; ++jt) { ab::glds16(ksrc + (size_t)jt * 64 * PITCH, (unsigned)__builtin_amdgcn_readfirstlane(kdst + jt * 8192)); ab::glds16(vsrc + (size_t)jt * 64 * PITCH, (unsigned)__builtin_amdgcn_readfirstlane(vdst + jt * 8192)); }
            build_lut4(F, h);
            asm volatile("s_waitcnt vmcnt(0) lgkmcnt(0)" ::: "memory");
            __syncthreads();
            staged = cur.pi;
        }
        int nv = cur.cnt - wid * 32; nv = nv < 0 ? 0 : (nv > 32 ? 32 : nv);
        const int t = ent >> 2;
        if (nv > 0) {
            LAS const float* lut = (LAS const float*)(F.lds + A_LUT) + h * 512;
            const bool anynear = __any(t < 256 * (n + 2)) != 0;
            const float rb31 = lut[511];
            float m = -1e30f, l = 0.f; f32x16 o[2]; o[0] = f32x16{}; o[1] = f32x16{};
            f32x16 pa0, pa1, pb0, pb1; float mra, mrb; bool nra, nrb;
#define P5_ISSUE(jt, q0, q1, mr, nr) do { nr = anynear && __any(t < 256 * n + 64 * (jt) + 63 + 113) != 0; mr = moff_of(m); f32x16 cc_; const float ci_ = (nr ? 0.f : rb31) - mr; \
                _Pragma("unroll") for (int r = 0; r < 16; ++r) cc_[r] = ci_; qkt2(q0, q1, F.lds + A_K + (jt) * 8192, qr, cc_, cc_, r32, hi); } while (0)
#define P5_FINISH(jt, q0, q1, mr, nr) do { if (nr) near_bias(q0, q1, F.lds, t - (256 * n + 64 * (jt) + 4 * hi)); softmax_pv(q0, q1, m, l, o, wsf, vb0 + (jt) * 8192, r32, hi, mr); } while (0)
            P5_ISSUE(0, pa0, pa1, mra, nra);
            P5_ISSUE(1, pb0, pb1, mrb, nrb); __builtin_amdgcn_sched_barrier(0);
            P5_FINISH(0, pa0, pa1, mra, nra);
            if (has_next) p5_q(qn, P, ent_n, nx.pi >> 6, hi);
            P5_ISSUE(2, pa0, pa1, mra, nra); __builtin_amdgcn_sched_barrier(0);
            P5_FINISH(1, pb0, pb1, mrb, nrb);
            P5_ISSUE(3, pb0, pb1, mrb, nrb); __builtin_amdgcn_sched_barrier(0);
            P5_FINISH(2, pa0, pa1, mra, nra);
            P5_FINISH(3, pb0, pb1, mrb, nrb);
#undef P5_ISSUE
#undef P5_FINISH
            { auto rr = __builtin_amdgcn_permlane32_swap(__float_as_uint(l), __float_as_uint(l), false, false); l = __uint_as_float(rr[0]) + __uint_as_float(rr[1]); }
            float rli[16];
#pragma unroll
            for (int r = 0; r < 16; ++r) rli[r] = 1.0f;
            stage_o(o, rli, stg, r32, hi);
            asm volatile("s_waitcnt lgkmcnt(0)" ::: "memory");
#pragma unroll
            for (int i = 0; i < 4; ++i) { const int row = i * 8 + (lane >> 3), ch = lane & 7; const int er = __shfl(ent, row);
                const u32x4 v = *(LAS const u32x4*)(stg + row * 64 + ch * 8);
                if (row < nv) *(u32x4*)(PO + (((size_t)h * SEQ + (er >> 2)) * 4 + (er & 3)) * 64 + ch * 8) = v; }
            if (hi == 0 && r32 < nv) { const size_t pi = ((size_t)h * SEQ + t) * 4 + (ent & 3); typedef float f32x2m __attribute__((ext_vector_type(2))); ((f32x2m*)PM)[pi] = (f32x2m){m, l}; }
            asm volatile("s_waitcnt lgkmcnt(0)" ::: "memory");
        } else if (has_next) p5_q(qn, P, ent_n, nx.pi >> 6, hi);
        cur = nx; ent = ent_n;
#pragma unroll
        for (int d0 = 0; d0 < 4; ++d0) qr[d0] = qn[d0];
    }
}
__device__ __forceinline__ void phase6(const Args& a, Frame& F, bool have_lut) {
    if (!have_lut) build_lut(a, F);
    for (int u = F.bid; u < NH * NMB; u += F.G) moba_item(a, F, u & 7, u >> 3, true, nullptr, 256);
}
__device__ __forceinline__ void phase8(const Args& a, Frame& F) {
    const float* mod = (const float*)(a.ws + WS_MOD);
    LAS float* part = (LAS float*)F.lds;
    LAS float* lg = (LAS float*)(F.lds + 65536);
    LAS int* hist = (LAS int*)(F.lds + X_OFF); LAS int* ebase = hist + 32; LAS int* rsel = hist + 64; LAS int* rrank = rsel + 256; LAS float* rgate = (LAS float*)(rrank + 256);
    const bf16* __restrict__ AO = (const bf16*)(a.ws + WS_AO);
    LAS unsigned char* LO = F.lds;
    const float* __restrict__ xin = a.in[0]; unsigned char* __restrict__ XN8 = a.ws + WS_XN8;
    const bf16* WH = (const bf16*)(a.ws + WS_WRT); const bf16* WL = WH + 32 * 1024;
    int* EIDX = (int*)(a.ws + WS_EIDX); float* GATE = (float*)(a.ws + WS_GATE); int* LOC = (int*)(a.ws + WS_LOC);
    const int lane = F.lane, r32 = lane & 31, hi = lane >> 5;
    LAS float* gv = (LAS float*)(F.lds + X_OFF + 4096);
    for (int i = F.tid; i < 1024; i += NWAVES * 64) { gv[i] = a.in[5][i] * mod[2048 + i]; gv[1024 + i] = a.in[10][i] * (mod[4096 + i] + 1.0f); gv[2048 + i] = mod[3072 + i]; }
    __syncthreads();
    const float rbias = a.in[13][F.tid & 31];
    for (int c_ = F.bid; c_ < NCHUNK; c_ += F.G) { const int c = vchunk(c_, F.G);
        if (F.tid < 32) hist[F.tid] = 0;
        auto LOADROW = [&](int rr, u32x2 (&av)[4], f32x4 (&xv)[4]) __attribute__((always_inline)) { const bool ok = rr < 8;
            const size_t ro = (size_t)(c * CHR + F.wave * 8 + (ok ? rr : 7)) * DM + (ok ? 4 * lane : 0);
#pragma unroll
            for (int j = 0; j < 4; ++j) { av[j] = __builtin_nontemporal_load((const u32x2*)(AO + ro + 256 * j)); xv[j] = __builtin_nontemporal_load((const f32x4*)(xin + ro + 256 * j)); } };
        auto ROW = [&](int rr, const u32x2 (&av)[4], const f32x4 (&xvv)[4]) __attribute__((always_inline)) {
            const int row = c * CHR + F.wave * 8 + rr;
            f32x4 y[4]; float ss = 0.f;
#pragma unroll
            for (int j = 0; j < 4; ++j) { const u32x2 v = av[j];
                y[j] = (f32x4){__uint_as_float(v.x << 16), __uint_as_float(v.x & 0xffff0000u), __uint_as_float(v.y << 16), __uint_as_float(v.y & 0xffff0000u)};
                ss += (y[j][0] * y[j][0] + y[j][1] * y[j][1]) + (y[j][2] * y[j][2] + y[j][3] * y[j][3]); }
            const float rs1 = 1.0f / sqrtf(wave_sum(ss) * (1.0f / DM) + RMS_EPS);
            if (lane == 0) ((float*)(a.ws + WS_RS1))[row] = rs1;
            float ss2 = 0.f;
#pragma unroll
            for (int j = 0; j < 4; ++j) { const int cc = 256 * j + 4 * lane; const f32x4 xv = xvv[j];
                const f32x4 ga = *(LAS const f32x4*)(gv + cc);
                y[j] = xv + (y[j] * rs1) * ga;
                ss2 += (y[j][0] * y[j][0] + y[j][1] * y[j][1]) + (y[j][2] * y[j][2] + y[j][3] * y[j][3]); }
            const float rs2 = 1.0f / sqrtf(wave_sum(ss2) * (1.0f / DM) + RMS_EPS);
#pragma unroll
            for (int j = 0; j < 4; ++j) { const int cc = 256 * j + 4 * lane;
                const f32x4 gb_ = *(LAS const f32x4*)(gv + 1024 + cc), gc_ = *(LAS const f32x4*)(gv + 2048 + cc);
                y[j] = (y[j] * rs2) * gb_ + gc_;
                const unsigned q8 = f8pk4(y[j][0] * S_A, y[j][1] * S_A, y[j][2] * S_A, y[j][3] * S_A); *(unsigned*)(XN8 + (size_t)row * DM + cc) = q8;
                const auto d0 = __builtin_amdgcn_cvt_pk_f32_fp8((int)q8, false), d1 = __builtin_amdgcn_cvt_pk_f32_fp8((int)q8, true);
                const f32x4 rsd = y[j] - (f32x4){d0[0], d0[1], d1[0], d1[1]} * (1.0f / S_A);
                u32x2 ol; ol.x = ab::cvtpk_s(rsd[0], rsd[1]); ol.y = ab::cvtpk_s(rsd[2], rsd[3]);
                { const int rl = F.wave * 8 + rr, ch = 32 * j + (lane >> 1); *(LAS u32x2*)(LO + rl * 2048 + ((ch ^ (rl & 15)) << 4) + ((lane & 1) << 3)) = ol; } }
        };
        { u32x2 aA[4], aB[4]; f32x4 xA[4], xB[4];
          LOADROW(0, aA, xA);
#pragma unroll 1
          for (int rr = 0; rr < 8; rr += 2) { LOADROW(rr + 1, aB, xB); ROW(rr, aA, xA); LOADROW(rr + 2, aA, xA); ROW(rr + 1, aB, xB); } }
        bf16x8 wh[8], wl[8];
        { const bf16* bh = WH + (size_t)r32 * DM + F.wave * 128 + hi * 8; const bf16* bl = WL + (size_t)r32 * DM + F.wave * 128 + hi * 8;
#pragma unroll
          for (int ks = 0; ks < 8; ++ks) { wh[ks] = *(const bf16x8*)(bh + 16 * ks); wl[ks] = *(const bf16x8*)(bl + 16 * ks); } }
        asm volatile("s_waitcnt vmcnt(0)" ::: "memory");
        __syncthreads();
        {
            f32x16 acc[2]; acc[0] = f32x16{}; acc[1] = f32x16{};
            const unsigned char* ah = XN8 + (size_t)(c * CHR + r32) * DM + F.wave * 128 + hi * 8;
#pragma unroll
            for (int kq = 0; kq < 2; ++kq) {
                bf16x8 xh[2][4], xl[2][4];
#pragma unroll
                for (int k4 = 0; k4 < 4; ++k4)
#pragma unroll
                    for (int rt = 0; rt < 2; ++rt) { const u32x2 h8 = *(const u32x2*)(ah + (size_t)(32 * rt) * DM + 16 * (4 * kq + k4));
                        const auto e0 = __builtin_amdgcn_cvt_pk_f32_fp8((int)h8.x, false), e1 = __builtin_amdgcn_cvt_pk_f32_fp8((int)h8.x, true), e2 = __builtin_amdgcn_cvt_pk_f32_fp8((int)h8.y, false), e3 = __builtin_amdgcn_cvt_pk_f32_fp8((int)h8.y, true);
                        const u32x4 hb = (u32x4){ab::cvtpk_s(e0[0] * (1.0f / S_A), e0[1] * (1.0f / S_A)), ab::cvtpk_s(e1[0] * (1.0f / S_A), e1[1] * (1.0f / S_A)), ab::cvtpk_s(e2[0] * (1.0f / S_A), e2[1] * (1.0f / S_A)), ab::cvtpk_s(e3[0] * (1.0f / S_A), e3[1] * (1.0f / S_A))};
                        xh[rt][k4] = __builtin_bit_cast(bf16x8, hb);
                        { const int rl = 32 * rt + r32, ch = F.wave * 16 + 2 * (4 * kq + k4) + hi; xl[rt][k4] = *(LAS const bf16x8*)(LO + rl * 2048 + ((ch ^ (rl & 15)) << 4)); } }
#pragma unroll
                for (int k4 = 0; k4 < 4; ++k4)
#pragma unroll
                    for (int rt = 0; rt < 2; ++rt) { const int ks = 4 * kq + k4;
                        acc[rt] = __builtin_amdgcn_mfma_f32_32x32x16_bf16(xh[rt][k4], wh[ks], acc[rt], 0, 0, 0);
                        acc[rt] = __builtin_amdgcn_mfma_f32_32x32x16_bf16(xh[rt][k4], wl[ks], acc[rt], 0, 0, 0);
                        acc[rt] = __builtin_amdgcn_mfma_f32_32x32x16_bf16(xl[rt][k4], wh[ks], acc[rt], 0, 0, 0); }
            }
            asm volatile("s_waitcnt lgkmcnt(0)" ::: "memory");
            __syncthreads();
#pragma unroll
            for (int rt = 0; rt < 2; ++rt)
#pragma unroll
                for (int r = 0; r < 16; ++r) part[(F.wave * 64 + 32 * rt + ab::crow(r, hi)) * 32 + r32] = acc[rt][r];
        }
        __syncthreads();
#pragma unroll
        for (int q = 0; q < 4; ++q) { const int idx = F.tid + 512 * q, row = idx >> 5, e = idx & 31; float s = rbias;
#pragma unroll
            for (int w = 0; w < 8; ++w) s += part[(w * 64 + row) * 32 + e];
            lg[row * 33 + e] = s; }
        __syncthreads();
        if (F.wave == 0) {
            float v0 = -INFINITY, v1 = -INFINITY, v2 = -INFINITY, v3 = -INFINITY; int i0 = 0, i1 = 0, i2 = 0, i3 = 0;
#pragma unroll
            for (int e = 0; e < 32; ++e) { const float g = lg[lane * 33 + e];
                const bool c0 = g > v0, c1 = g > v1, c2 = g > v2, c3 = g > v3;
                v3 = c2 ? v2 : (c3 ? g : v3); i3 = c2 ? i2 : (c3 ? e : i3);
                v2 = c1 ? v1 : (c2 ? g : v2); i2 = c1 ? i1 : (c2 ? e : i2);
                v1 = c0 ? v0 : (c1 ? g : v1); i1 = c0 ? i0 : (c1 ? e : i1);
                v0 = c0 ? g : v0; i0 = c0 ? e : i0; }
            const float e1 = __expf(v1 - v0), e2 = __expf(v2 - v0), e3 = __expf(v3 - v0); const float inv = 1.0f / (1.0f + e1 + e2 + e3);
            rsel[lane * 4 + 0] = i0; rsel[lane * 4 + 1] = i1; rsel[lane * 4 + 2] = i2; rsel[lane * 4 + 3] = i3;
            rgate[lane * 4 + 0] = inv; rgate[lane * 4 + 1] = e1 * inv; rgate[lane * 4 + 2] = e2 * inv; rgate[lane * 4 + 3] = e3 * inv;
            rrank[lane * 4 + 0] = (int)__hip_atomic_fetch_add(hist + i0, 1, __ATOMIC_RELAXED, __HIP_MEMORY_SCOPE_WORKGROUP);
            rrank[lane * 4 + 1] = (int)__hip_atomic_fetch_add(hist + i1, 1, __ATOMIC_RELAXED, __HIP_MEMORY_SCOPE_WORKGROUP);
            rrank[lane * 4 + 2] = (int)__hip_atomic_fetch_add(hist + i2, 1, __ATOMIC_RELAXED, __HIP_MEMORY_SCOPE_WORKGROUP);
            rrank[lane * 4 + 3] = (int)__hip_atomic_fetch_add(hist + i3, 1, __ATOMIC_RELAXED, __HIP_MEMORY_SCOPE_WORKGROUP);
        }
        __syncthreads();
        if (F.tid < 32) { const int hc = hist[F.tid]; ebase[F.tid] = hc > 0 ? (int)__hip_atomic_fetch_add((unsigned*)(F.ctl + CW_ECNT + F.tid * 64), (unsigned)hc, __ATOMIC_RELAXED, __HIP_MEMORY_SCOPE_AGENT) : 0; }
        __syncthreads();
        if (F.tid < 256) { const int e = rsel[F.tid]; const size_t gi = (size_t)(c * CHR) * 4 + F.tid; const int loc = ebase[e] + rrank[F.tid]; EIDX[gi] = e; LOC[gi] = loc; GATE[gi] = rgate[F.tid];
            ((int*)(a.ws + WS_ELIST))[e * 16384 + loc] = c * CHR + (F.tid >> 2); }
        __syncthreads();
    }
}

__device__ __forceinline__ int moe_layout(Frame& F, LAS int* pstart, LAS int* tileE) {
    if (F.tid < 64) {
        const int e = F.tid, cn = e < NE ? (int)__hip_atomic_load(F.ctl + CW_ECNT + e * 64, RLX_AGENT) : 0, nt = (cn + 255) >> 8;
        int inc = nt;
#pragma unroll
        for (int o = 1; o < 32; o <<= 1) { const int y = __shfl_up(inc, o); if (e >= o) inc += y; }
        const int t0 = inc - nt;
        if (e < NE) { pstart[64 + e] = cn; pstart[e] = t0 * 256; for (int i = 0; i < nt; ++i) tileE[t0 + i] = e; }
        if (e == NE - 1) { pstart[NE] = inc * 256; pstart[NE + 1] = inc; }
    }
    __syncthreads();
    return pstart[NE + 1];
}
__device__ __forceinline__ void phase12(const Args& a, Frame& F, bool have_layout) {
    const float* mod = (const float*)(a.ws + WS_MOD);
    const bf16* __restrict__ Y = (const bf16*)(a.ws + WS_Y); const int* __restrict__ EIDX = (const int*)(a.ws + WS_EIDX); const int* __restrict__ LOC = (const int*)(a.ws + WS_LOC); const float* __restrict__ GATE = (const float*)(a.ws + WS_GATE);
    LAS int* pstart = (LAS int*)(F.lds + X_OFF); LAS int* tileE = pstart + 128;
    if (!have_layout) (void)moe_layout(F, pstart, tileE);
    f32x4 GF[4], GA[4];
#pragma unroll
    for (int j = 0; j < 4; ++j) { const int c = 256 * j + 4 * F.lane; GF[j] = *(const f32x4*)(a.in[11] + c) * *(const f32x4*)(mod + 5120 + c);
        GA[j] = *(const f32x4*)(a.in[5] + c) * *(const f32x4*)(mod + 2048 + c); }
    const bf16* __restrict__ AO = (const bf16*)(a.ws + WS_AO); const float* __restrict__ xin = a.in[0]; const float* __restrict__ RS1 = (const float*)(a.ws + WS_RS1);
    const int gw = F.bid * NWAVES + F.wave, NGW = F.G * NWAVES;
    for (int tb = gw; tb < SEQ; tb += 16 * NGW) {
    int posL = 0; float gateL = 0.f;
    { const int tt = tb + (F.lane >> 2) * NGW; if (tt < SEQ) { const int ix = tt * 4 + (F.lane & 3); posL = pstart[EIDX[ix]] + LOC[ix]; gateL = GATE[ix] * (FP8M ? 1.0f / S_Y : 1.0f); } }
    if constexpr (FP8M) {
    auto LOAD = [&](int ti, unsigned (&yv)[16], u32x2 (&av)[4], f32x4 (&xv)[4], float& r1) __attribute__((always_inline)) {
        int t = tb + ti * NGW; t = t < SEQ ? t : SEQ - 1;
#pragma unroll
        for (int k = 0; k < 4; ++k) { const int pos = __shfl(posL, (ti * 4 + k) & 63);
#pragma unroll
            for (int j = 0; j < 4; ++j) yv[k * 4 + j] = __builtin_nontemporal_load((const unsigned*)((const unsigned char*)Y + (size_t)pos * DM + 256 * j + 4 * F.lane)); }
#pragma unroll
        for (int j = 0; j < 4; ++j) { const int cc = 256 * j + 4 * F.lane;
            av[j] = __builtin_nontemporal_load((const u32x2*)(AO + (size_t)t * DM + cc)); xv[j] = __builtin_nontemporal_load((const f32x4*)(xin + (size_t)t * DM + cc)); }
        r1 = RS1[t];
    };
    auto FIN = [&](int ti, const unsigned (&yv)[16], const u32x2 (&av)[4], const f32x4 (&xv)[4], float r1) __attribute__((always_inline)) {
        const int t = tb + ti * NGW;
        f32x4 y[4];
#pragma unroll
        for (int j = 0; j < 4; ++j) y[j] = (f32x4){0.f, 0.f, 0.f, 0.f};
#pragma unroll
        for (int k = 0; k < 4; ++k) { const float gk = __shfl(gateL, ti * 4 + k);
#pragma unroll
            for (int j = 0; j < 4; ++j) { const unsigned v = yv[k * 4 + j];
                const auto lo = __builtin_amdgcn_cvt_pk_f32_fp8((int)v, false), hi2 = __builtin_amdgcn_cvt_pk_f32_fp8((int)v, true);
                y[j] += (f32x4){lo[0], lo[1], hi2[0], hi2[1]} * gk; } }
        float ss = 0.f;
#pragma unroll
        for (int j = 0; j < 4; ++j) ss += (y[j][0] * y[j][0] + y[j][1] * y[j][1]) + (y[j][2] * y[j][2] + y[j][3] * y[j][3]);
        const float rs = 1.0f / sqrtf(wave_sum(ss) * (1.0f / DM) + RMS_EPS);
        float* __restrict__ orow = a.out + (size_t)t * DM + 4 * F.lane;
#pragma unroll
        for (int j = 0; j < 4; ++j) {
            const f32x4 ao = (f32x4){__uint_as_float(av[j].x << 16), __uint_as_float(av[j].x & 0xffff0000u), __uint_as_float(av[j].y << 16), __uint_as_float(av[j].y & 0xffff0000u)};
            const f32x4 x1 = xv[j] + (ao * r1) * GA[j];
            __builtin_nontemporal_store(x1 + (y[j] * rs) * GF[j], (f32x4*)(orow + 256 * j)); }
    };
    unsigned yA[16], yB[16]; u32x2 aA[4], aB[4]; f32x4 xA[4], xB[4]; float rA = 0.f, rB = 0.f;
    LOAD(0, yA, aA, xA, rA);
#pragma unroll 1
    for (int ti = 0; ti < 16; ti += 2) {
        if (tb + ti * NGW >= SEQ) break;
        LOAD(ti + 1, yB, aB, xB, rB);
        FIN(ti, yA, aA, xA, rA);
        if (tb + (ti + 1) * NGW >= SEQ) break;
        LOAD(ti + 2, yA, aA, xA, rA);
        FIN(ti + 1, yB, aB, xB, rB);
    }
    } else {
#pragma unroll 2
    for (int ti = 0; ti < 16; ++ti) {
        const int t = tb + ti * NGW; if (t >= SEQ) break;
        f32x4 y[4];
#pragma unroll
        for (int j = 0; j < 4; ++j) y[j] = (f32x4){0.f, 0.f, 0.f, 0.f};
#pragma unroll
        for (int k = 0; k < 4; ++k) { const int pos = __shfl(posL, ti * 4 + k); const float gk = __shfl(gateL, ti * 4 + k);
#pragma unroll
            for (int j = 0; j < 4; ++j) {
                if constexpr (FP8M) { const unsigned v = __builtin_nontemporal_load((const unsigned*)((const unsigned char*)Y + (size_t)pos * DM + 256 * j + 4 * F.lane));
                    const auto lo = __builtin_amdgcn_cvt_pk_f32_fp8((int)v, false), hi2 = __builtin_amdgcn_cvt_pk_f32_fp8((int)v, true);
                    y[j] += (f32x4){lo[0], lo[1], hi2[0], hi2[1]} * gk; }
                else { const u32x2 v = __builtin_nontemporal_load((const u32x2*)(Y + (size_t)pos * DM + 256 * j + 4 * F.lane));
                    y[j] += (f32x4){__uint_as_float(v.x << 16), __uint_as_float(v.x & 0xffff0000u), __uint_as_float(v.y << 16), __uint_as_float(v.y & 0xffff0000u)} * gk; } } }
        float ss = 0.f;
#pragma unroll
        for (int j = 0; j < 4; ++j) ss += (y[j][0] * y[j][0] + y[j][1] * y[j][1]) + (y[j][2] * y[j][2] + y[j][3] * y[j][3]);
        const float rs = 1.0f / sqrtf(wave_sum(ss) * (1.0f / DM) + RMS_EPS);
        float* __restrict__ orow = a.out + (size_t)t * DM + 4 * F.lane; const float r1 = RS1[t];
#pragma unroll
        for (int j = 0; j < 4; ++j) { const int cc = 256 * j + 4 * F.lane;
            const u32x2 av = __builtin_nontemporal_load((const u32x2*)(AO + (size_t)t * DM + cc)); const f32x4 xv = __builtin_nontemporal_load((const f32x4*)(xin + (size_t)t * DM + cc));
            const f32x4 ao = (f32x4){__uint_as_float(av.x << 16), __uint_as_float(av.x & 0xffff0000u), __uint_as_float(av.y << 16), __uint_as_float(av.y & 0xffff0000u)};
            const f32x4 x1 = xv + (ao * r1) * GA[j];
            __builtin_nontemporal_store(x1 + (y[j] * rs) * GF[j], (f32x4*)(orow + 256 * j)); }
    }
    }
    }
}

constexpr int NPHASE = 13;
__global__ void __launch_bounds__(NWAVES * 64, 2) fwd_kernel(Args args) {
    extern __shared__ __attribute__((aligned(16))) unsigned char lds[];
    Frame F;
    F.lds = (LAS unsigned char*)lds;
    F.tid = threadIdx.x; F.lane = F.tid & 63; F.wave = __builtin_amdgcn_readfirstlane(F.tid >> 6);
    F.G = gridDim.x; F.bid = blockIdx.x;
    F.ctl = (gu32*)(args.ws + WS_CTL);
    volatile LAS unsigned* MISC = (volatile LAS unsigned*)(F.lds + MISC_OFF);
    if (F.tid < 64) MISC[F.tid] = 0u;
    __syncthreads();
    const int lo = args.ph_lo, hi = args.ph_hi;
    const bool multi = (hi - lo) > 1;
    XcdBarrier bar; bar.bar = (unsigned*)(F.ctl + CW_BAR); bar.x = 0; bar.st = nullptr;
    if (multi) bar = xcd_barrier_post((unsigned*)(F.ctl + CW_BAR), MISC + 8);
#define IN(k) (lo <= (k) && (k) < hi)
#define SEAM(k) do { if (IN(k) && IN((k) + 1)) xcd_barrier(bar); } while (0)
    const pg8::bf16_t* XNp = (const pg8::bf16_t*)(args.ws + WS_XN);

    if (IN(0)) { phase0(args, F); SEAM(0); }
    if (IN(1)) { phase1(args, F); SEAM(1); }
    if (IN(2)) {
        cum_chunks(args, F);
        pg8::Gemm g{XNp, (const pg8::bf16_t*)(args.ws + WS_WTIN), SEQ, PITCH, DM}; pg8::StaticOrder S; S.init(SEQ, PITCH, F.G, F.bid);
        pg8::EpiProj E{(pg8::bf16_t*)(args.ws + WS_PROJ), PITCH, C2, (float*)(F.ctl + CW_KMS), (unsigned*)(F.ctl + CW_KN2H), (unsigned*)(F.ctl + CW_QN2H)};
        if (side_gu(F.G)) { const unsigned m8 = __builtin_amdgcn_readfirstlane(MISC[8]), m9 = __builtin_amdgcn_readfirstlane(MISC[9]);
            pg8::gemm_phase<pg8::EpiProj, pg8::StaticOrder, PG8_ALIGN, true, pg8::SideCvt>(F.lds, g, S, E, side_make(args, F, 0, 24));
            if (F.tid == 0) { MISC[8] = m8; MISC[9] = m9; } }
        else pg8::gemm_phase<pg8::EpiProj, pg8::StaticOrder, PG8_ALIGN, PG8_SP2>(F.lds, g, S, E);
        SEAM(2);
    }
    if (IN(4)) { phase4(args, F); if (!IN(5)) SEAM(4); }
    if (IN(5)) { phase5(args, F, IN(4)); SEAM(5); }
    if (IN(6)) { phase6(args, F, IN(5)); SEAM(6); }
    if (IN(7)) {
        pg8::Gemm g{(const pg8::bf16_t*)(args.ws + WS_MIX), (const pg8::bf16_t*)(args.ws + WS_WTOUT), SEQ, DM, DM}; pg8::StaticOrder S; S.init(SEQ, DM, F.G, F.bid);
        pg8::EpiBf16<0> E{(pg8::bf16_t*)(args.ws + WS_AO), DM, nullptr, 0, 0, 1.f};
        if (side_gu(F.G)) { const unsigned m8 = __builtin_amdgcn_readfirstlane(MISC[8]), m9 = __builtin_amdgcn_readfirstlane(MISC[9]);
            pg8::gemm_phase<pg8::EpiBf16<0>, pg8::StaticOrder, PG8_ALIGN, true, pg8::SideCvt>(F.lds, g, S, E, side_make(args, F, 24, 8));
            if (F.tid == 0) { MISC[8] = m8; MISC[9] = m9; } }
        else pg8::gemm_phase<pg8::EpiBf16<0>, pg8::StaticOrder, PG8_ALIGN, PG8_SP2>(F.lds, g, S, E);
        SEAM(7);
    }
    if (IN(8)) { phase8(args, F); SEAM(8); }
    if (IN(10)) {
        LAS int* pstart = (LAS int*)(F.lds + X_OFF); LAS int* tileE = pstart + 128; LAS int* xrow = (LAS int*)(F.lds + X_OFF + 2048);
        const int T = __builtin_amdgcn_readfirstlane(moe_layout(F, pstart, tileE));
        const int groups = (F.G % 8 == 0) ? 8 : 1, per = F.G / groups;
        pg8::MoeSched<true> S{tileE, T, 8, groups == 8 ? (F.bid & 7) : 0, groups == 8 ? (F.bid >> 3) : F.bid, per, groups, 13};
        { pg8::Unit u; const int* EL = (const int*)(args.ws + WS_ELIST);
          const int tl = F.tid & 255, par = F.tid >> 8; int rv[7]; unsigned upper = 0u;
#pragma unroll
          for (int k = 0; k < 7; ++k) { const int i = 2 * k + par; rv[k] = 0;
              if (S.next(i, u)) { const int lt = u.pm - (pstart[u.e] >> 8), nvalid = pstart[64 + u.e] - lt * 256; if (tl < nvalid) rv[k] = EL[u.e * 16384 + lt * 256 + tl]; if (u.nh == 2) upper |= 1u << k; } }
#pragma unroll
          for (int k = 0; k < 7; ++k) { const int i = 2 * k + par; if (i < 13) xrow[i * 256 + (((upper >> k) & 1u) ? (tl ^ 128) : tl)] = rv[k]; }
          __syncthreads(); }
        pg8::Gemm2 g{FP8M ? (const unsigned char*)(args.ws + WS_XN8) : (const unsigned char*)(args.ws + WS_XN), (const unsigned char*)(args.ws + WS_WTGU), DM, xrow};
        pg8::EpiSwiglu E{args.ws + WS_ACT, args.in[15], 1.0f / (S_A * S_W), F.lds + X_OFF + 16384};
        pg8::gemm_phase2<pg8::EpiSwiglu, pg8::MoeSched<true>, PG8_ALIGN, FP8M, true>(F.lds, g, S, E);
        SEAM(10);
    }
    if (IN(11)) {
        LAS int* pstart = (LAS int*)(F.lds + X_OFF); LAS int* tileE = pstart + 128;
        const int T = __builtin_amdgcn_readfirstlane(IN(10) ? pstart[NE + 1] : moe_layout(F, pstart, tileE));
        const int groups = (F.G % 8 == 0) ? 8 : 1, per = F.G / groups;
        pg8::MoeSched<true> S{tileE, T, 4, groups == 8 ? (F.bid & 7) : 0, groups == 8 ? (F.bid >> 3) : F.bid, per, groups, 1 << 30};
        pg8::Gemm2 g{(const unsigned char*)(args.ws + WS_ACT), (const unsigned char*)(args.ws + WS_WTDN), DM, nullptr};
        pg8::EpiDown E{args.ws + WS_Y, args.in[17], 1.0f / (S_ACT * S_W), F.lds + X_OFF + 16384};
        pg8::gemm_phase2<pg8::EpiDown, pg8::MoeSched<true>, PG8_ALIGN, FP8M, false>(F.lds, g, S, E);
        SEAM(11);
    }
    if (IN(12)) { phase12(args, F, IN(10) || IN(11)); }
#undef IN
#undef SEAM
}

#ifndef MK_PER_PHASE
#define MK_PER_PHASE 0
#endif
extern "C" void kernel_launch(void* const* d_in, const int* in_sizes, int n_in, void* d_out, int out_size, void* d_ws, size_t ws_size, hipStream_t stream) {
    static int grid = 0;
    if (grid == 0) {
        if (n_in != 18 || in_sizes[0] != SEQ * DM || out_size != SEQ * DM || ws_size < WS_END) { fprintf(stderr, "kernel_launch: unexpected shapes (n_in %d, in0 %d, out %d, ws %zu); nothing launched\n", n_in, n_in > 0 ? in_sizes[0] : -1, out_size, ws_size); grid = -1; return; }
        int dev = 0, cus = 0, per_cu = 0;
        if (hipGetDevice(&dev) != hipSuccess || hipDeviceGetAttribute(&cus, hipDeviceAttributeMultiprocessorCount, dev) != hipSuccess) { grid = -1; return; }
        if (hipFuncSetAttribute((const void*)fwd_kernel, hipFuncAttributeMaxDynamicSharedMemorySize, LDS_BYTES) != hipSuccess) { fprintf(stderr, "kernel_launch: hipFuncSetAttribute failed\n"); grid = -1; return; }
        if (hipOccupancyMaxActiveBlocksPerMultiprocessor(&per_cu, (const void*)fwd_kernel, NWAVES * 64, LDS_BYTES) != hipSuccess || per_cu < 1) { fprintf(stderr, "kernel_launch: occupancy query reports %d workgroups per CU\n", per_cu); }
        (void)hipGetLastError();
        grid = cus;
    }
    if (grid < 0) return;
    if (hipMemsetAsync((char*)d_ws + WS_CTL, 0, CTL_ZERO_BYTES, stream) != hipSuccess) return;
    Args a{};
    for (int i = 0; i < 18; ++i) a.in[i] = (const float*)d_in[i];
    a.out = (float*)d_out; a.ws = (unsigned char*)d_ws;
#if MK_PER_PHASE
    for (int p = 0; p < NPHASE; ++p) { a.ph_lo = p; a.ph_hi = p + 1; hipLaunchKernelGGL(fwd_kernel, dim3(grid), dim3(NWAVES * 64), LDS_BYTES, stream, a); }
#else
    a.ph_lo = 0; a.ph_hi = NPHASE; hipLaunchKernelGGL(fwd_kernel, dim3(grid), dim3(NWAVES * 64), LDS_BYTES, stream, a);
#endif
}
```
